# Optimizing an MI355X kernel written in HIP

```python
import math
import jax, jax.numpy as jnp
from jax import lax
import numpy as np

D_MODEL = 2048
BATCH = 4
SEQ = 4096
DEPTH = 4

CHUNK = 64
Q_BLOCK = 128
D_MIX = D_MODEL
D_POOL = D_MIX // 2
D_DIFF = D_MIX - D_POOL
POOL_WINDOWS = (2, 4, 8, 16)
N_POOL_GROUPS = len(POOL_WINDOWS)
POOL_GROUP_DIM = D_POOL // N_POOL_GROUPS
DIFF_HEADS = 8
DIFF_V_DIM = D_DIFF // DIFF_HEADS
DIFF_QK_DIM = DIFF_V_DIM // 2
D_QK = DIFF_HEADS * 2 * DIFF_QK_DIM
D_IN = 2 * D_POOL + 2 * D_QK + 2 * D_DIFF
ROPE_THETA = 10000.0
EPS = 1e-6
NEG_INF = -1e30

kernel_name = "hybrid_pool_diffattn_sandwich_adaln"


def rms_norm(x, g):
    xf = x.astype(jnp.float32)
    y = xf * lax.rsqrt(jnp.mean(xf * xf, axis=-1, keepdims=True) + EPS)
    return (y * g.astype(jnp.float32)).astype(x.dtype)


def rope_tables(positions):
    inv_freq = 1.0 / (ROPE_THETA ** (jnp.arange(0, DIFF_QK_DIM, 2, dtype=jnp.float32) / DIFF_QK_DIM))
    ang = positions.astype(jnp.float32)[..., None] * inv_freq
    emb = jnp.concatenate([ang, ang], axis=-1)[:, :, None, None, :]
    return jnp.cos(emb), jnp.sin(emb)


def apply_rope(x, cos, sin):
    xf = x.astype(jnp.float32)
    half = DIFF_QK_DIM // 2
    rot = jnp.concatenate([-xf[..., half:], xf[..., :half]], axis=-1)
    return (xf * cos + rot * sin).astype(x.dtype)


def multiscale_pool(u, w_pool, pool_scale):
    B, S, _ = u.shape
    ug = u.reshape(B, S, N_POOL_GROUPS, POOL_GROUP_DIM).astype(jnp.float32)
    t1 = jnp.arange(1, S + 1, dtype=jnp.int32)
    outs = []
    for g, w in enumerate(POOL_WINDOWS):
        xg = ug[:, :, g]
        cs = jnp.cumsum(xg, axis=1)
        cs_lag = jnp.pad(cs, ((0, 0), (w, 0), (0, 0)))[:, :S]
        count = jnp.minimum(t1, w).astype(jnp.float32)[None, :, None]
        outs.append((cs - cs_lag) / count - xg)
    pooled = jnp.stack(outs, axis=2)
    mixed = jnp.einsum('bsgc,gcd->bsgd', pooled, w_pool.astype(jnp.float32))
    mixed = mixed * pool_scale.astype(jnp.float32).reshape(N_POOL_GROUPS, POOL_GROUP_DIM)
    return mixed.reshape(B, S, D_POOL).astype(u.dtype)


def diff_attention(q, k, v, lam):
    B, S = q.shape[0], q.shape[1]
    nb = S // Q_BLOCK
    scale = 1.0 / math.sqrt(DIFF_QK_DIM)
    q_blocks = jnp.moveaxis(q.reshape(B, nb, Q_BLOCK, DIFF_HEADS, 2, DIFF_QK_DIM), 1, 0)
    key_chunk = jnp.arange(S, dtype=jnp.int32) // CHUNK
    vf = v.astype(jnp.float32)
    kf = k.astype(jnp.float32)

    def block(args):
        qblk, bidx = args
        q_chunk = (bidx * Q_BLOCK + jnp.arange(Q_BLOCK, dtype=jnp.int32)) // CHUNK
        mask = key_chunk[None, :] <= q_chunk[:, None]
        s = jnp.einsum('bqhmd,bkhmd->bhmqk', qblk.astype(jnp.float32), kf) * scale
        s = jnp.where(mask[None, None, None], s, NEG_INF)
        p = jax.nn.softmax(s, axis=-1)
        a = p[:, :, 0] - lam * p[:, :, 1]
        return jnp.einsum('bhqk,bkhd->bqhd', a, vf)

    out = lax.map(block, (q_blocks, jnp.arange(nb, dtype=jnp.int32)))
    out = jnp.moveaxis(out, 0, 1).reshape(B, S, DIFF_HEADS, DIFF_V_DIM)
    return out.astype(v.dtype)


def hybrid_layer(x, c, cos, sin, layer_idx, w_ada, b_ada, g_pre, w_in, w_pool, pool_scale,
                 lq1, lk1, lq2, lk2, subln_g, w_out, g_post):
    B, S, _ = x.shape
    mod = (c @ w_ada + b_ada)[:, None, :]
    shift, scale, gate = jnp.split(mod, 3, axis=-1)
    h = rms_norm(x, g_pre) * (1 + scale) + shift

    z = h @ w_in
    splits = np.cumsum([D_POOL, D_POOL, D_QK, D_QK, D_DIFF]).tolist()
    u, g_pool, q, k, v, g_diff = jnp.split(z, splits, axis=-1)

    pool_out = multiscale_pool(u, w_pool, pool_scale) * jax.nn.silu(g_pool)

    lam_init = 0.8 - 0.6 * math.exp(-0.3 * layer_idx)
    lam = (jnp.exp(jnp.sum(lq1.astype(jnp.float32) * lk1.astype(jnp.float32)))
           - jnp.exp(jnp.sum(lq2.astype(jnp.float32) * lk2.astype(jnp.float32))) + lam_init)
    q = apply_rope(q.reshape(B, S, DIFF_HEADS, 2, DIFF_QK_DIM), cos, sin)
    k = apply_rope(k.reshape(B, S, DIFF_HEADS, 2, DIFF_QK_DIM), cos, sin)
    v = v.reshape(B, S, DIFF_HEADS, DIFF_V_DIM)
    att = diff_attention(q, k, v, lam)
    att = rms_norm(att, subln_g) * (1.0 - lam_init)
    diff_out = att.reshape(B, S, D_DIFF) * jax.nn.silu(g_diff)

    y = jnp.concatenate([pool_out, diff_out], axis=-1) @ w_out
    return x + (1 + gate) * rms_norm(y, g_post)


def setup_inputs(seed: int = 0) -> dict:
    key = jax.random.key(seed)
    ks = jax.random.split(key, 20)
    f32 = jnp.float32
    nrm = lambda k, shape, s: jax.random.normal(k, shape, f32) * s
    x = jax.random.normal(ks[0], (BATCH, SEQ, D_MODEL), f32)
    c = jax.random.normal(ks[1], (BATCH, D_MODEL), f32)
    offset = jax.random.randint(ks[2], (BATCH, 1), 0, 8192, dtype=jnp.int32)
    positions = offset + jnp.arange(SEQ, dtype=jnp.int32)[None, :]
    return {
        "x": x,
        "c": c,
        "positions": positions,
        "w_ada": nrm(ks[3], (DEPTH, D_MODEL, 3 * D_MODEL), 0.1 * D_MODEL ** -0.5),
        "b_ada": nrm(ks[4], (DEPTH, 3 * D_MODEL), 0.01),
        "g_pre": 1.0 + nrm(ks[5], (DEPTH, D_MODEL), 0.02),
        "w_in": nrm(ks[6], (DEPTH, D_MODEL, D_IN), D_MODEL ** -0.5),
        "w_pool": nrm(ks[7], (DEPTH, N_POOL_GROUPS, POOL_GROUP_DIM, POOL_GROUP_DIM), POOL_GROUP_DIM ** -0.5),
        "pool_scale": 1.0 + nrm(ks[8], (DEPTH, D_POOL), 0.02),
        "lambda_q1": nrm(ks[9], (DEPTH, DIFF_QK_DIM), 0.1),
        "lambda_k1": nrm(ks[10], (DEPTH, DIFF_QK_DIM), 0.1),
        "lambda_q2": nrm(ks[11], (DEPTH, DIFF_QK_DIM), 0.1),
        "lambda_k2": nrm(ks[12], (DEPTH, DIFF_QK_DIM), 0.1),
        "subln_g": 1.0 + nrm(ks[13], (DEPTH, DIFF_V_DIM), 0.02),
        "w_out": nrm(ks[14], (DEPTH, D_MIX, D_MODEL), D_MIX ** -0.5),
        "g_post": 1.0 + nrm(ks[15], (DEPTH, D_MODEL), 0.02),
    }


def reference(x, c, positions, w_ada, b_ada, g_pre, w_in, w_pool, pool_scale,
              lambda_q1, lambda_k1, lambda_q2, lambda_k2, subln_g, w_out, g_post):
    cos, sin = rope_tables(positions)
    for l in range(DEPTH):
        x = hybrid_layer(x, c, cos, sin, l, w_ada[l], b_ada[l], g_pre[l], w_in[l], w_pool[l],
                         pool_scale[l], lambda_q1[l], lambda_k1[l], lambda_q2[l], lambda_k2[l],
                         subln_g[l], w_out[l], g_post[l])
    return x
```

```cpp
#include <hip/hip_runtime.h>
#include <hip/hip_cooperative_groups.h>
#include <hip/hip_bf16.h>
#include <cstdio>
#include <cstdint>
#include <cstddef>
#include <cmath>
namespace pg8 {
#define PG8_LAS __attribute__((address_space(3)))
typedef unsigned short bf16_t;
typedef short bf16x8 __attribute__((ext_vector_type(8)));
typedef float f32x4 __attribute__((ext_vector_type(4)));
typedef unsigned u32x4 __attribute__((ext_vector_type(4)));
constexpr int BM = 256, BK = 64, HALF = 128, HTB = HALF * BK * 2  , STAGE_BYTES = 8 * HTB, NXCD = 8, WGM = 8;

__host__ __device__ __forceinline__ int lds_byte(int r, int c) { const int st = (r >> 4) * 2 + (c >> 5), rr = r & 15, cc = c & 31, ob = rr * 64 + cc * 2; return st * 1024 + (ob ^ (((ob >> 9) & 1) << 5)); }
__host__ __device__ __forceinline__ void stage_rc(int b, int& R, int& C) { const int st = b / 1024, sb = b % 1024, swz = sb ^ (((sb >> 9) & 1) << 5); R = (st >> 1) * 16 + swz / 64; C = (st & 1) * 32 + (swz % 64) / 2; }
__host__ __device__ __forceinline__ int perm32(int rho) { const int n = rho >> 4, i = rho & 15; return 8 * (i >> 2) + 4 * n + (i & 3); }

struct Unit { int pm, pn; };
struct Gemm { const bf16_t* A; const bf16_t* Bt; int M, N, K; };

struct StaticOrder {
    int nM, nN, nwg, G, c;
    __host__ __device__ void init(int M, int N, int G_, int c_) { nM = M / BM; nN = N / BM; nwg = nM * nN; G = G_; c = c_; }
    __host__ __device__ bool next(int i, Unit& u) const {
        const long L = (long)i * G + c; if (L >= nwg) return false;
        int wgid = (int)L; { const int q = nwg / NXCD, r = nwg % NXCD, xcd = wgid % NXCD, off = wgid / NXCD; wgid = (xcd < r ? xcd * (q + 1) : r * (q + 1) + (xcd - r) * q) + off; }
        const int nig = WGM * nN, gid = wgid / nig, fm = gid * WGM, gsz = (nM - fm) < WGM ? (nM - fm) : WGM;
        u.pm = fm + ((wgid % nig) % gsz); u.pn = (wgid % nig) / gsz; return true;
    }
    __device__ __forceinline__ void a_ready(const Unit&) const {}
    __device__ __forceinline__ void done(const Unit&) const {}
};

__device__ __forceinline__ unsigned cvt_pk_bf16(float lo, float hi) { unsigned r; asm volatile("v_cvt_pk_bf16_f32 %0, %1, %2" : "=v"(r) : "v"(lo), "v"(hi)); return r; }
typedef unsigned u32x2 __attribute__((ext_vector_type(2)));
__device__ __forceinline__ float bf_lo(unsigned w) { return __uint_as_float(w << 16); }
__device__ __forceinline__ float bf_hi(unsigned w) { return __uint_as_float(w & 0xffff0000u); }
__device__ __forceinline__ float silu_f(float g) { return g * __builtin_amdgcn_rcpf(1.0f + __builtin_amdgcn_exp2f(-1.4426950408889634f * g)); }

struct EpiPlain {
    static constexpr bool PERM = true, AFTER_DRAIN = false;
    bf16_t* O; int ldc;
    __device__ __forceinline__ void operator()(const f32x4 (&acc)[2][2][4][2], const Unit& u, int wr, int wc, int fr, int fq) const {
        const int row0 = u.pm * BM + wr * 64 + fr; const int col0 = u.pn * BM + wc * 32 + 8 * fq;
#pragma unroll
        for (int ai = 0; ai < 2; ++ai)
#pragma unroll
            for (int m = 0; m < 4; ++m) { bf16_t* rowp = O + (size_t)(row0 + ai * HALF + m * 16) * ldc + col0;
#pragma unroll
                for (int bj = 0; bj < 2; ++bj) { const f32x4 v0 = acc[ai][bj][m][0], v1 = acc[ai][bj][m][1];
                    u32x4 w; w.x = cvt_pk_bf16(v0[0], v0[1]); w.y = cvt_pk_bf16(v0[2], v0[3]); w.z = cvt_pk_bf16(v1[0], v1[1]); w.w = cvt_pk_bf16(v1[2], v1[3]);
                    *(u32x4*)(rowp + bj * HALF) = w; } }
    }
};

struct EpiInProj {
    static constexpr bool PERM = true, AFTER_DRAIN = false;
    bf16_t* Z; size_t zstride; const float* cosT; const float* sinT; float qscale;
    __device__ __forceinline__ void operator()(const f32x4 (&acc)[2][2][4][2], const Unit& u, int wr, int wc, int fr, int fq) const {
        const int row0 = u.pm * BM + wr * 64 + fr; const int t = u.pn >> 2; const int colt = (u.pn & 3) * BM;
        bf16_t* base = Z + (size_t)t * zstride;
        if (t == 2 || t == 3) {
            const float sc = (t == 2) ? qscale : 1.0f; const int g = 4 * (wc & 1) + fq;
#pragma unroll
            for (int ai = 0; ai < 2; ++ai)
#pragma unroll
                for (int m = 0; m < 4; ++m) { const int r = row0 + ai * HALF + m * 16;
                    f32x4 cs = *(const f32x4*)(cosT + (size_t)r * 32 + 4 * g), sn = *(const f32x4*)(sinT + (size_t)r * 32 + 4 * g); cs = cs * sc; sn = sn * sc;
#pragma unroll
                    for (int bj = 0; bj < 2; ++bj) { const f32x4 v0 = acc[ai][bj][m][0], v1 = acc[ai][bj][m][1];
                        const f32x4 o0 = v0 * cs - v1 * sn, o1 = v1 * cs + v0 * sn;
                        bf16_t* p = base + (size_t)r * 1024 + colt + bj * HALF + (wc >> 1) * 64 + 4 * g;
                        u32x2 w0, w1; w0.x = cvt_pk_bf16(o0[0], o0[1]); w0.y = cvt_pk_bf16(o0[2], o0[3]); w1.x = cvt_pk_bf16(o1[0], o1[1]); w1.y = cvt_pk_bf16(o1[2], o1[3]);
                        *(u32x2*)p = w0; *(u32x2*)(p + 32) = w1; } }
        } else {
            const int col0 = colt + wc * 32 + 8 * fq;
#pragma unroll
            for (int ai = 0; ai < 2; ++ai)
#pragma unroll
                for (int m = 0; m < 4; ++m) { bf16_t* rowp = base + (size_t)(row0 + ai * HALF + m * 16) * 1024 + col0;
#pragma unroll
                    for (int bj = 0; bj < 2; ++bj) { const f32x4 v0 = acc[ai][bj][m][0], v1 = acc[ai][bj][m][1];
                        u32x4 w; w.x = cvt_pk_bf16(v0[0], v0[1]); w.y = cvt_pk_bf16(v0[2], v0[3]); w.z = cvt_pk_bf16(v1[0], v1[1]); w.w = cvt_pk_bf16(v1[2], v1[3]);
                        *(u32x4*)(rowp + bj * HALF) = w; } }
        }
    }
};

struct EpiPool {
    static constexpr bool PERM = true, AFTER_DRAIN = false;
    bf16_t* MIX; const bf16_t* GP; const float* ps;
    __device__ __forceinline__ void operator()(const f32x4 (&acc)[2][2][4][2], const Unit& u, int wr, int wc, int fr, int fq) const {
        const int grp = u.pm >> 6; const int tok0 = (u.pm & 63) * BM + wr * 64 + fr; const int col0 = grp * 256 + wc * 32 + 8 * fq;
        f32x4 sv[2][2];
#pragma unroll
        for (int bj = 0; bj < 2; ++bj)
#pragma unroll
            for (int n = 0; n < 2; ++n) sv[bj][n] = *(const f32x4*)(ps + col0 + bj * HALF + 4 * n);
#pragma unroll
        for (int ai = 0; ai < 2; ++ai)
#pragma unroll
            for (int m = 0; m < 4; ++m) { const size_t tok = (size_t)(tok0 + ai * HALF + m * 16);
#pragma unroll
                for (int bj = 0; bj < 2; ++bj) { const int col = col0 + bj * HALF;
                    const u32x4 gv = *(const u32x4*)(GP + tok * 1024 + col);
                    const f32x4 v0 = acc[ai][bj][m][0] * sv[bj][0], v1 = acc[ai][bj][m][1] * sv[bj][1];
                    u32x4 w;
                    w.x = cvt_pk_bf16(v0[0] * silu_f(bf_lo(gv.x)), v0[1] * silu_f(bf_hi(gv.x))); w.y = cvt_pk_bf16(v0[2] * silu_f(bf_lo(gv.y)), v0[3] * silu_f(bf_hi(gv.y)));
                    w.z = cvt_pk_bf16(v1[0] * silu_f(bf_lo(gv.z)), v1[1] * silu_f(bf_hi(gv.z))); w.w = cvt_pk_bf16(v1[2] * silu_f(bf_lo(gv.w)), v1[3] * silu_f(bf_hi(gv.w)));
                    *(u32x4*)(MIX + tok * 2048 + col) = w; }
                asm volatile("" ::: "memory"); }
    }
};
struct PoolOrder {
    int G, c;
    __device__ __forceinline__ bool next(int i, Unit& u) const { const int L = i * G + c; if (L >= 256) return false; u.pm = L; u.pn = L >> 6; return true; }
    __device__ __forceinline__ void a_ready(const Unit&) const {}
    __device__ __forceinline__ void done(const Unit&) const {}
};

template <class Epi, class Sched, bool ALIGN_EPI = false, bool SP2 = false>
__device__ __forceinline__ void gemm_phase(PG8_LAS unsigned char* lds, const Gemm g, const Sched& S, const Epi& E) {
    int tid_ = threadIdx.x; asm volatile("" : "+v"(tid_));
    const int tid = tid_, wid = __builtin_amdgcn_readfirstlane(tid >> 6), lane = tid & 63, wr = wid >> 2, wc = wid & 3, fr = lane & 15, fq = lane >> 4;
    const int K = g.K, nt = K / BK;
    unsigned voffA[2], voffB[2];
#pragma unroll
    for (int i = 0; i < 2; ++i) { int R, C; stage_rc(tid * 16 + i * 8192, R, C); const int Rb = Epi::PERM ? ((R & ~31) + perm32(R & 31)) : R;
        voffA[i] = (unsigned)(R * K + C) * 2u; voffB[i] = (unsigned)(Rb * K + C) * 2u; }
    const size_t kstep = (size_t)(BK * 2);
    const size_t hstep = (size_t)HALF * K * 2;
    const size_t tstep = 2 * hstep;
    const unsigned ldsw = (unsigned)wid * 1024u;
    const int aoff = lds_byte(wr * 64 + fr, fq * 8), boff = lds_byte(wc * 32 + fr, fq * 8);
#define PG8_SA(b, h) (((b) * 2 + (h)) * HTB)
#define PG8_SB(b, h) ((4 + (b) * 2 + (h)) * HTB)
#define PG8_STAGE(bufoff, gbase, voff) do { _Pragma("unroll") for (int _i = 0; _i < 2; ++_i) \
        __builtin_amdgcn_global_load_lds((const unsigned*)((const char*)(gbase) + (voff)[_i]), (PG8_LAS unsigned*)(lds + (bufoff) + ldsw + _i * 8192), 16, 0, 0); } while (0)
#define PG8_LDA(dst, b, h) do { _Pragma("unroll") for (int m = 0; m < 4; ++m) _Pragma("unroll") for (int k = 0; k < 2; ++k) dst[m][k] = *(const PG8_LAS bf16x8*)(lds + PG8_SA(b, h) + aoff + m * 2048 + k * 1024); } while (0)
#define PG8_LDB(dst, b, h) do { _Pragma("unroll") for (int n = 0; n < 2; ++n) _Pragma("unroll") for (int k = 0; k < 2; ++k) dst[n][k] = *(const PG8_LAS bf16x8*)(lds + PG8_SB(b, h) + boff + n * 2048 + k * 1024); } while (0)
#define PG8_MMA(ai, bj, At, Bt) do { __builtin_amdgcn_s_setprio(1); _Pragma("unroll") for (int m = 0; m < 4; ++m) _Pragma("unroll") for (int n = 0; n < 2; ++n) _Pragma("unroll") for (int k = 0; k < 2; ++k) \
        acc[ai][bj][m][n] = __builtin_amdgcn_mfma_f32_16x16x32_bf16(Bt[n][k], At[m][k], acc[ai][bj][m][n], 0, 0, 0); __builtin_amdgcn_s_setprio(0); } while (0)
#define PG8_WAIT_V(n) asm volatile("s_waitcnt vmcnt(" #n ")" ::: "memory")
#define PG8_WAIT_L(n) asm volatile("s_waitcnt lgkmcnt(" #n ")" ::: "memory")
#define PG8_BAR __builtin_amdgcn_s_barrier()
#define PG8_SCHED __builtin_amdgcn_sched_barrier(0)
    Unit cur, nxt; int ui = 0;
    if (!S.next(0, cur)) return;
    f32x4 acc[2][2][4][2];
#pragma unroll
    for (int a = 0; a < 2; ++a)
#pragma unroll
        for (int b = 0; b < 2; ++b)
#pragma unroll
            for (int m = 0; m < 4; ++m)
#pragma unroll
                for (int n = 0; n < 2; ++n) acc[a][b][m][n] = (f32x4){0.f, 0.f, 0.f, 0.f};
    bf16x8 At[4][2], B0[2][2], B1[2][2];
    const char* cA = (const char*)g.A + (size_t)cur.pm * tstep; const char* cB = (const char*)g.Bt + (size_t)cur.pn * tstep;
    S.a_ready(cur);
    if constexpr (SP2) {
        PG8_STAGE(PG8_SB(0, 0), cB, voffB); PG8_STAGE(PG8_SB(0, 1), cB + hstep, voffB); PG8_STAGE(PG8_SA(0, 0), cA, voffA); PG8_STAGE(PG8_SA(0, 1), cA + hstep, voffA);
        if (wr == 1) PG8_BAR;
        PG8_WAIT_V(2); PG8_BAR;
        PG8_STAGE(PG8_SB(1, 0), cB + kstep, voffB); PG8_STAGE(PG8_SA(1, 0), cA + kstep, voffA); PG8_STAGE(PG8_SB(1, 1), cB + hstep + kstep, voffB);
        PG8_WAIT_V(6); PG8_BAR;
    } else {
        PG8_STAGE(PG8_SB(0, 0), cB, voffB); PG8_STAGE(PG8_SA(0, 0), cA, voffA); PG8_STAGE(PG8_SB(0, 1), cB + hstep, voffB); PG8_STAGE(PG8_SA(0, 1), cA + hstep, voffA);
        if (wr == 1) PG8_BAR;
        PG8_WAIT_V(4); PG8_BAR;
        PG8_STAGE(PG8_SB(1, 0), cB + kstep, voffB); PG8_STAGE(PG8_SA(1, 0), cA + kstep, voffA); PG8_STAGE(PG8_SB(1, 1), cB + hstep + kstep, voffB);
        PG8_WAIT_V(6); PG8_BAR;
    }
    for (;;) {
        const bool has_next = S.next(ui + 1, nxt);
        const char* nA = has_next ? (const char*)g.A + (size_t)nxt.pm * tstep : cA; const char* nB = has_next ? (const char*)g.Bt + (size_t)nxt.pn * tstep : cB;
        for (int t = 0; t < nt; t += 2) {
            const bool last = (t == nt - 2);
            const char* a1 = cA + (size_t)(t + 1) * kstep;
            const char* a2 = last ? nA : cA + (size_t)(t + 2) * kstep; const char* b2 = last ? nB : cB + (size_t)(t + 2) * kstep;
            const char* a3 = a2 + kstep; const char* b3 = b2 + kstep;
            if (last && has_next) S.a_ready(nxt);
            if constexpr (SP2) {
            PG8_LDB(B0, 0, 0); PG8_LDB(B1, 0, 1); PG8_SCHED; PG8_LDA(At, 0, 0); PG8_STAGE(PG8_SA(1, 1), a1 + hstep, voffA);
            PG8_WAIT_V(8); PG8_WAIT_L(0); PG8_BAR; PG8_MMA(0, 0, At, B0); PG8_MMA(0, 1, At, B1); PG8_BAR; PG8_SCHED;
            PG8_LDA(At, 0, 1); PG8_STAGE(PG8_SB(0, 0), b2, voffB); PG8_STAGE(PG8_SB(0, 1), b2 + hstep, voffB); PG8_STAGE(PG8_SA(0, 0), a2, voffA);
            PG8_WAIT_V(8); PG8_WAIT_L(0); PG8_BAR; PG8_MMA(1, 0, At, B0); PG8_MMA(1, 1, At, B1); PG8_BAR; PG8_SCHED;
            PG8_LDB(B0, 1, 0); PG8_LDB(B1, 1, 1); PG8_SCHED; PG8_LDA(At, 1, 0); PG8_STAGE(PG8_SA(0, 1), a2 + hstep, voffA);
            PG8_WAIT_V(8); PG8_WAIT_L(0); PG8_BAR; PG8_MMA(0, 0, At, B0); PG8_MMA(0, 1, At, B1); PG8_BAR; PG8_SCHED;
            PG8_LDA(At, 1, 1); PG8_STAGE(PG8_SB(1, 0), b3, voffB); PG8_STAGE(PG8_SB(1, 1), b3 + hstep, voffB); PG8_STAGE(PG8_SA(1, 0), a3, voffA);
            PG8_WAIT_V(8); PG8_WAIT_L(0); PG8_BAR; PG8_MMA(1, 0, At, B0); PG8_MMA(1, 1, At, B1); PG8_BAR; PG8_SCHED;
            } else {
            PG8_LDB(B0, 0, 0); PG8_SCHED; PG8_LDA(At, 0, 0); PG8_STAGE(PG8_SA(1, 1), a1 + hstep, voffA);
            PG8_WAIT_L(8); PG8_BAR; PG8_WAIT_L(0); PG8_MMA(0, 0, At, B0); PG8_BAR; PG8_SCHED;
            PG8_LDB(B1, 0, 1); PG8_STAGE(PG8_SB(0, 0), b2, voffB);
            PG8_BAR; PG8_WAIT_L(0); PG8_MMA(0, 1, At, B1); PG8_BAR;
            PG8_LDA(At, 0, 1); PG8_STAGE(PG8_SA(0, 0), a2, voffA);
            PG8_BAR; PG8_WAIT_L(0); PG8_MMA(1, 0, At, B0); PG8_BAR; PG8_SCHED;
            PG8_STAGE(PG8_SB(0, 1), b2 + hstep, voffB);
            PG8_WAIT_V(6); PG8_BAR; PG8_MMA(1, 1, At, B1); PG8_BAR;
            PG8_LDB(B0, 1, 0); PG8_SCHED; PG8_LDA(At, 1, 0); PG8_STAGE(PG8_SA(0, 1), a2 + hstep, voffA);
            PG8_WAIT_L(8); PG8_BAR; PG8_WAIT_L(0); PG8_MMA(0, 0, At, B0); PG8_BAR; PG8_SCHED;
            PG8_LDB(B1, 1, 1); PG8_STAGE(PG8_SB(1, 0), b3, voffB);
            PG8_BAR; PG8_WAIT_L(0); PG8_MMA(0, 1, At, B1); PG8_BAR;
            PG8_LDA(At, 1, 1); PG8_STAGE(PG8_SA(1, 0), a3, voffA);
            PG8_BAR; PG8_WAIT_L(0); PG8_MMA(1, 0, At, B0); PG8_BAR; PG8_SCHED;
            PG8_STAGE(PG8_SB(1, 1), b3 + hstep, voffB);
            PG8_WAIT_V(6); PG8_BAR; PG8_MMA(1, 1, At, B1); PG8_BAR;
            }
        }
        if constexpr (ALIGN_EPI) { if (wr == 0) PG8_BAR; }
        if constexpr (!Epi::AFTER_DRAIN) { E(acc, cur, wr, wc, fr, fq); S.done(cur); }
        if (!has_next) break;
#pragma unroll
        for (int a = 0; a < 2; ++a)
#pragma unroll
            for (int b = 0; b < 2; ++b)
#pragma unroll
                for (int m = 0; m < 4; ++m)
#pragma unroll
                    for (int n = 0; n < 2; ++n) acc[a][b][m][n] = (f32x4){0.f, 0.f, 0.f, 0.f};
        cur = nxt; cA = nA; cB = nB; ++ui;
        if constexpr (ALIGN_EPI) { if (wr == 1) PG8_BAR; }
    }
    PG8_WAIT_V(0);
    if constexpr (!ALIGN_EPI) { if (wr == 0) PG8_BAR; }
    PG8_BAR;
    if constexpr (Epi::AFTER_DRAIN) { E.fused(acc, cur, wr, wc, fr, fq, lds, wid, lane); S.done(cur); }
#undef PG8_SA
#undef PG8_SB
#undef PG8_STAGE
#undef PG8_LDA
#undef PG8_LDB
#undef PG8_MMA
#undef PG8_WAIT_V
#undef PG8_WAIT_L
#undef PG8_BAR
#undef PG8_SCHED
}
}
namespace attn_body {
using bf16=__hip_bfloat16;
using bf16x8=__attribute__((ext_vector_type(8)))short;
using s16x4=__attribute__((ext_vector_type(4)))short;
using f32x16=__attribute__((ext_vector_type(16)))float;
using u32x4=__attribute__((ext_vector_type(4)))unsigned;
constexpr int BATCH=4,NHEAD=16,SEQ=4096,D=64,DM=NHEAD*D;
constexpr int NW=8,QBLK=32,QB=QBLK*NW,KVBLK=64,NQB=SEQ/QB;
constexpr int ATTN_PITCH=DM, ATTN_UNIT_ROWS=QB;
__device__ __forceinline__ int crow(int r,int hi){return (r&3)+8*(r>>2)+4*hi;}
#define SBAR() __builtin_amdgcn_sched_barrier(0)
__device__ __forceinline__ void cmask(f32x16&p0,f32x16&p1,int jb,int qrel,int hi){
  const float NEG=-INFINITY; int kb=64*jb+4*hi;
  #pragma unroll
  for(int r=0;r<16;++r){int kv=kb+(r&3)+8*(r>>2); if(kv>(qrel|63))p0[r]=NEG; if(kv+32>(qrel|63))p1[r]=NEG;}
}

constexpr int NSLOT=3, SLOTB=8192;
constexpr int LDS_K=0, LDS_V=NSLOT*SLOTB, LDS_WS=2*NSLOT*SLOTB, LDS_OST=LDS_WS+NW*64*4, LDS_BYTES=LDS_OST+NW*4096;
constexpr float C2=0.125f*1.4426950408889634f;
__device__ __forceinline__ void glds16(const void*gsrc,unsigned lds_dst){unsigned keep;
  asm volatile("s_mov_b32 %0, m0\n\ts_mov_b32 m0, %2\n\ts_nop 0\n\tglobal_load_lds_dwordx4 %1, off\n\ts_mov_b32 m0, %0":"=&s"(keep):"v"(gsrc),"s"(lds_dst):"memory");}
__device__ __forceinline__ float max3f(float a,float b,float c){float r;asm("v_max3_f32 %0, %1, %2, %3":"=v"(r):"v"(a),"v"(b),"v"(c));return r;}
__device__ __forceinline__ float max2f(float a,float b){float r;asm("v_max_f32_e32 %0, %1, %2":"=v"(r):"v"(a),"v"(b));return r;}
__device__ __forceinline__ float fadd_s(float a,float b){float r;asm("v_add_f32_e32 %0, %1, %2":"=v"(r):"v"(a),"v"(b));return r;}
__device__ __forceinline__ float fsub_s(float a,float b){float r;asm("v_sub_f32_e32 %0, %1, %2":"=v"(r):"v"(a),"v"(b));return r;}
typedef float f32x2_t __attribute__((ext_vector_type(2))); typedef __bf16 bf16x2_t __attribute__((ext_vector_type(2)));
__device__ __forceinline__ unsigned cvtpk_s(float lo,float hi){f32x2_t v={lo,hi};bf16x2_t b=__builtin_convertvector(v,bf16x2_t);return __builtin_bit_cast(unsigned,b);}
#define WAIT_BAR(N) asm volatile("s_waitcnt vmcnt(" #N ") lgkmcnt(0)\n\ts_barrier":::"memory")

__device__ __forceinline__ void qkt(f32x16&p0,f32x16&p1,const char*Kslot,const bf16x8*qr,const f32x16&negm,int r32,int hi){
  const char*kb=Kslot+hi*1024+r32*16;
  #pragma unroll
  for(int d0=0;d0<4;++d0){
    const bf16x8 b0=*reinterpret_cast<const bf16x8*>(kb+d0*2048);
    const bf16x8 b1=*reinterpret_cast<const bf16x8*>(kb+d0*2048+512);
    if(d0==0){p0=__builtin_amdgcn_mfma_f32_32x32x16_bf16(b0,qr[0],negm,0,0,0);p1=__builtin_amdgcn_mfma_f32_32x32x16_bf16(b1,qr[0],negm,0,0,0);}
    else{p0=__builtin_amdgcn_mfma_f32_32x32x16_bf16(b0,qr[d0],p0,0,0,0);p1=__builtin_amdgcn_mfma_f32_32x32x16_bf16(b1,qr[d0],p1,0,0,0);}}
}
typedef __attribute__((address_space(3))) const char* lds_cptr;
typedef short v4i16_t __attribute__((ext_vector_type(4)));
__device__ __forceinline__ void kload8(bf16x8*kf,lds_cptr kp){
  kf[0]=*(const __attribute__((address_space(3))) bf16x8*)(kp);      kf[1]=*(const __attribute__((address_space(3))) bf16x8*)(kp+512);
  kf[2]=*(const __attribute__((address_space(3))) bf16x8*)(kp+2048); kf[3]=*(const __attribute__((address_space(3))) bf16x8*)(kp+2560);
  kf[4]=*(const __attribute__((address_space(3))) bf16x8*)(kp+4096); kf[5]=*(const __attribute__((address_space(3))) bf16x8*)(kp+4608);
  kf[6]=*(const __attribute__((address_space(3))) bf16x8*)(kp+6144); kf[7]=*(const __attribute__((address_space(3))) bf16x8*)(kp+6656);
}
__device__ __forceinline__ void kload2(bf16x8*kf,lds_cptr kp,int j){ kf[2*j]=*(const __attribute__((address_space(3))) bf16x8*)(kp+j*2048); kf[2*j+1]=*(const __attribute__((address_space(3))) bf16x8*)(kp+j*2048+512); }
__device__ __forceinline__ s16x4 vtr(lds_cptr p){ return __builtin_bit_cast(s16x4,__builtin_amdgcn_ds_read_tr16_b64_v4i16((__attribute__((address_space(3))) v4i16_t*)p)); }
__device__ __forceinline__ float rowmax(const f32x16&p0,const f32x16&p1){
  float a=max3f(p0[0],p0[1],p1[0]),b=max3f(p0[2],p0[3],p1[1]);a=max3f(a,p1[2],p1[3]);
  #pragma unroll
  for(int r=4;r<16;r+=4){a=max3f(a,p0[r],p0[r+1]);b=max3f(b,p0[r+2],p0[r+3]);a=max3f(a,p1[r],p1[r+1]);b=max3f(b,p1[r+2],p1[r+3]);}
  const float m=max2f(a,b);
  auto rr=__builtin_amdgcn_permlane32_swap(__float_as_uint(m),__float_as_uint(m),false,false);
  return max2f(__uint_as_float(rr[0]),__uint_as_float(rr[1]));
}
__device__ __forceinline__ void pv(f32x16*o,int vb,bf16x8 pa0,bf16x8 pa1,bf16x8 pa2,bf16x8 pa3){
  #pragma unroll
  for(int d0=0;d0<2;++d0){s16x4 lo[4],hi[4];
    #pragma unroll
    for(int ks=0;ks<4;++ks){
      asm volatile("ds_read_b64_tr_b16 %0,%1 offset:%c2":"=&v"(lo[ks]):"v"(vb),"i"(d0*4096+ks*1024):"memory");
      asm volatile("ds_read_b64_tr_b16 %0,%1 offset:%c2":"=&v"(hi[ks]):"v"(vb),"i"(d0*4096+ks*1024+512):"memory");}
    asm volatile("s_waitcnt lgkmcnt(0)":::"memory");SBAR();
    #define PK(k) (bf16x8){lo[k][0],lo[k][1],lo[k][2],lo[k][3],hi[k][0],hi[k][1],hi[k][2],hi[k][3]}
    o[d0]=__builtin_amdgcn_mfma_f32_32x32x16_bf16(pa0,PK(0),o[d0],0,0,0);
    o[d0]=__builtin_amdgcn_mfma_f32_32x32x16_bf16(pa1,PK(1),o[d0],0,0,0);
    o[d0]=__builtin_amdgcn_mfma_f32_32x32x16_bf16(pa2,PK(2),o[d0],0,0,0);
    o[d0]=__builtin_amdgcn_mfma_f32_32x32x16_bf16(pa3,PK(3),o[d0],0,0,0);
    #undef PK
  }
}

#ifndef ATTN_STORE16
#define ATTN_STORE16(p,v) (*(u32x4*)(p)=(v))
#endif
template<int THRL> __device__ __forceinline__ void attn_unit(int b,int hq,int hv,int qb,const bf16*__restrict__ Q,const bf16*__restrict__ K,const bf16*__restrict__ V,bf16*__restrict__ O,char*shm){
  int tid_=threadIdx.x; asm volatile("":"+v"(tid_)); const int tid=tid_,lane=tid&63,r32=lane&31,hi=lane>>5; const int wid=__builtin_amdgcn_readfirstlane(tid>>6);
  const long rowbase=(long)b*SEQ; const int q0=qb*QB;
  const bf16*Qw=Q+(rowbase+q0+wid*QBLK)*DM+hq*D;
  const bf16*Kh=K+rowbase*DM+hq*D,*Vh=V+rowbase*DM+hv*D;
  const unsigned lds0=(unsigned)(uintptr_t)shm;
  float*wsf=(float*)(shm+LDS_WS)+wid*64;
  const bf16*ksrc=Kh+(long)lane*DM+wid*8;
  const bf16*vsrc=Vh+(long)(16*(wid&3)+(lane>>2))*DM+(wid>>2)*32+(lane&3)*8;
  const unsigned kdst=lds0+LDS_K+wid*1024, vdst=lds0+LDS_V+wid*1024;
  #define DMA_K(t,slot) glds16(ksrc+(long)(t)*KVBLK*DM,(unsigned)__builtin_amdgcn_readfirstlane(kdst+(slot)))
  #define DMA_V(t,slot) glds16(vsrc+(long)(t)*KVBLK*DM,(unsigned)__builtin_amdgcn_readfirstlane(vdst+(slot)))
  const int vb0=(int)(lds0+LDS_V)+((lane>>4)&1)*32+(lane&3)*8+(4*hi+((lane&15)>>2))*64;
  const char*Kbase=shm+LDS_K; bf16x8 kf[8];
  const lds_cptr shm3=(lds_cptr)shm; const lds_cptr kp0=shm3+LDS_K+hi*1024+r32*16; const lds_cptr vp0=shm3+LDS_V+((lane>>4)&1)*32+(lane&3)*8+(4*hi+((lane&15)>>2))*64;
  const int NT=(q0+QB)/KVBLK;
  DMA_K(0,0);DMA_V(0,0);DMA_K(1,SLOTB);
  bf16x8 qr[4];
  #pragma unroll
  for(int d0=0;d0<4;++d0)qr[d0]=*reinterpret_cast<const bf16x8*>(&Qw[(long)r32*DM+d0*16+hi*8]);
  float mhat=0.f,l_reg=0.f;f32x16 o[2];o[0]=f32x16{};o[1]=f32x16{};f32x16 negm=f32x16{};asm volatile("":"+v"(negm));
  const int qrel=wid*QBLK+r32;
  #define CMASK(P0,P1,t) do{int jb_=(t)-(NT-4); if(jb_>=0)cmask(P0,P1,jb_,qrel,hi);}while(0)
  bool resc=false;
  #define START(P0,P1) do{ const float rm=rowmax(P0,P1); resc=false; \
    { const float dl=rm; mhat=fadd_s(mhat,dl); \
      _Pragma("unroll") for(int r=0;r<16;++r){P0[r]=fsub_s(P0[r],dl);P1[r]=fsub_s(P1[r],dl);} \
      _Pragma("unroll") for(int r=0;r<16;++r)negm[r]=-mhat; asm volatile("":"+v"(negm)); } \
    _Pragma("unroll") for(int r=0;r<16;++r)P0[r]=__builtin_amdgcn_exp2f(P0[r]); }while(0)
  #define RESC() do{ if(resc){ asm volatile("s_waitcnt lgkmcnt(0)":::"memory"); \
      _Pragma("unroll") for(int d_=0;d_<2;++d_) _Pragma("unroll") for(int r=0;r<16;++r)o[d_][r]*=wsf[crow(r,hi)]; } }while(0)
  f32x16 pA0,pA1,pB0,pB1;
  int sl_prev=0,sl_cur=0,sl_next=SLOTB;
  #define ROT() do{sl_prev=sl_cur;sl_cur=sl_next;sl_next=(sl_next==(NSLOT-1)*SLOTB)?0:sl_next+SLOTB;}while(0)
  DMA_K(2,2*SLOTB);
  WAIT_BAR(3);
  qkt(pA0,pA1,Kbase,qr,negm,r32,hi);asm volatile("s_nop 15\n\ts_nop 7":"+v"(pA0),"+v"(pA1));CMASK(pA0,pA1,0);
  START(pA0,pA1);
  _Pragma("unroll") for(int r=0;r<16;++r)pA1[r]=__builtin_amdgcn_exp2f(pA1[r]);
  WAIT_BAR(0);
  DMA_K(3,0);DMA_V(1,SLOTB);
  ROT();
  kload8(kf,kp0+sl_cur);
  WAIT_BAR(2);
  s16x4 vlo[8],vhi[8]; u32x4 pw0,pw1,pw2,pw3;
  #define PKW(P,B) cvtpk_s(P[B],P[B+1])
  #define PAF(k) __builtin_bit_cast(bf16x8,pw##k)
  #define VFR(i) (bf16x8){vlo[i][0],vlo[i][1],vlo[i][2],vlo[i][3],vhi[i][0],vhi[i][1],vhi[i][2],vhi[i][3]}
  #define PIN(x) asm volatile("":"+v"(x))
  #define MX3(a,b,c) __builtin_fmaxf(__builtin_fmaxf((a),(b)),(c))
  #define GAPA(MF,A0,A1,A2,A3,W0,W1,PW) do{ MF; sacc+=A0; sacc+=A1; sacc+=A2; sacc+=A3; PIN(sacc); W0; W1; PIN(PW); SBAR(); }while(0)
  #define EX(v) __builtin_amdgcn_exp2f(v)
  #define GAPB(MF,X,B) do{ MF; X[B]=EX(X[B]); X[B+1]=EX(X[B+1]); X[B+2]=EX(X[B+2]); X[B+3]=EX(X[B+3]); PIN(X); SBAR(); }while(0)
  #define VRD(i) do{ vlo[i]=vtr(vp_+(((i)>>2)*4096+((i)&3)*1024)); vhi[i]=vtr(vp_+(((i)>>2)*4096+((i)&3)*1024+512)); }while(0)
  #define KRD(G,j) do{ if(G){ kload2(kf,kp0+sl_next,j); SBAR(); } }while(0)
  #define STEP(C0,C1,P0,P1,t,GK,GV,GL) do{ SBAR(); \
    const lds_cptr vp_=vp0+sl_prev; \
    VRD(0); SBAR(); float sacc=(P0[0]+P0[1]); \
    GAPA(C0=__builtin_amdgcn_mfma_f32_32x32x16_bf16(kf[0],qr[0],negm,0,0,0), P0[2],P0[3],P0[4],P0[5],     pw0[0]=PKW(P0,0), pw0[1]=PKW(P0,2), pw0); \
    VRD(4); SBAR(); GAPA(C1=__builtin_amdgcn_mfma_f32_32x32x16_bf16(kf[1],qr[0],negm,0,0,0), P0[6],P0[7],P0[8],P0[9],     pw0[2]=PKW(P0,4), pw0[3]=PKW(P0,6), pw0); \
    VRD(1); SBAR(); GAPA(C0=__builtin_amdgcn_mfma_f32_32x32x16_bf16(kf[2],qr[1],C0,0,0,0),   P0[10],P0[11],P0[12],P0[13], pw1[0]=PKW(P0,8), pw1[1]=PKW(P0,10), pw1); \
    VRD(5); SBAR(); GAPA(C1=__builtin_amdgcn_mfma_f32_32x32x16_bf16(kf[3],qr[1],C1,0,0,0),   P0[14],P0[15],P1[0],P1[1],   pw1[2]=PKW(P0,12),pw1[3]=PKW(P0,14), pw1); \
    VRD(2); SBAR(); GAPA(C0=__builtin_amdgcn_mfma_f32_32x32x16_bf16(kf[4],qr[2],C0,0,0,0),   P1[2],P1[3],P1[4],P1[5],     pw2[0]=PKW(P1,0), pw2[1]=PKW(P1,2), pw2); \
    VRD(6); SBAR(); GAPA(C1=__builtin_amdgcn_mfma_f32_32x32x16_bf16(kf[5],qr[2],C1,0,0,0),   P1[6],P1[7],P1[8],P1[9],     pw2[2]=PKW(P1,4), pw2[3]=PKW(P1,6), pw2); \
    VRD(3); SBAR(); GAPA(C0=__builtin_amdgcn_mfma_f32_32x32x16_bf16(kf[6],qr[3],C0,0,0,0),   P1[10],P1[11],P1[12],P1[13], pw3[0]=PKW(P1,8), pw3[1]=PKW(P1,10), pw3); \
    VRD(7); SBAR(); GAPA(C1=__builtin_amdgcn_mfma_f32_32x32x16_bf16(kf[7],qr[3],C1,0,0,0),   P1[14],P1[15],0.f,0.f,       pw3[2]=PKW(P1,12),pw3[3]=PKW(P1,14), pw3); \
    l_reg+=sacc; \
    if(GK){DMA_K((t)+3,sl_cur);} if(GV){DMA_V((t)+1,sl_next);} \
    CMASK(C0,C1,t); \
    { float a=MX3(C0[0],C0[1],C1[0]),b=MX3(C0[2],C0[3],C1[1]); a=MX3(a,C1[2],C1[3]); \
      _Pragma("unroll") for(int r=4;r<16;r+=4){a=MX3(a,C0[r],C0[r+1]);b=MX3(b,C0[r+2],C0[r+3]);a=MX3(a,C1[r],C1[r+1]);b=MX3(b,C1[r+2],C1[r+3]);} \
      float rm=__builtin_fmaxf(a,b); { auto rr=__builtin_amdgcn_permlane32_swap(__float_as_uint(rm),__float_as_uint(rm),false,false); rm=__builtin_fmaxf(__uint_as_float(rr[0]),__uint_as_float(rr[1])); } \
      resc=false; \
      if(__builtin_expect(__any(rm>(float)THRL),0)){ const float dl=__builtin_fmaxf(rm,0.f); mhat+=dl; \
        _Pragma("unroll") for(int r=0;r<16;++r){C0[r]-=dl;C1[r]-=dl;} \
        _Pragma("unroll") for(int r=0;r<16;++r)negm[r]=-mhat; asm volatile("":"+v"(negm)); \
        const float f=__builtin_amdgcn_exp2f(-dl); l_reg*=f; if(hi==0)wsf[r32]=f; resc=true; } } \
    SBAR(); \
    GAPB(o[0]=__builtin_amdgcn_mfma_f32_32x32x16_bf16(PAF(0),VFR(0),o[0],0,0,0), C0,0); \
    GAPB(o[1]=__builtin_amdgcn_mfma_f32_32x32x16_bf16(PAF(0),VFR(4),o[1],0,0,0), C0,4); \
    KRD(GL,0); GAPB(o[0]=__builtin_amdgcn_mfma_f32_32x32x16_bf16(PAF(1),VFR(1),o[0],0,0,0), C0,8); \
    KRD(GL,1); GAPB(o[1]=__builtin_amdgcn_mfma_f32_32x32x16_bf16(PAF(1),VFR(5),o[1],0,0,0), C0,12); \
    KRD(GL,2); GAPB(o[0]=__builtin_amdgcn_mfma_f32_32x32x16_bf16(PAF(2),VFR(2),o[0],0,0,0), C1,0); \
    KRD(GL,3); GAPB(o[1]=__builtin_amdgcn_mfma_f32_32x32x16_bf16(PAF(2),VFR(6),o[1],0,0,0), C1,4); \
    GAPB(o[0]=__builtin_amdgcn_mfma_f32_32x32x16_bf16(PAF(3),VFR(3),o[0],0,0,0), C1,8); \
    GAPB(o[1]=__builtin_amdgcn_mfma_f32_32x32x16_bf16(PAF(3),VFR(7),o[1],0,0,0), C1,12); \
    }while(0)
  int t=1;
  #undef CMASK
  #define CMASK(P0,P1,t) do{}while(0)
  for(;t+5<NT;t+=2){
    STEP(pB0,pB1,pA0,pA1,t,true,true,true);     WAIT_BAR(2); RESC(); ROT();
    STEP(pA0,pA1,pB0,pB1,t+1,true,true,true);   WAIT_BAR(2); RESC(); ROT();
  }
  #undef CMASK
  #define CMASK(P0,P1,t) do{int jb_=(t)-(NT-4); if(jb_>=0)cmask(P0,P1,jb_,qrel,hi);}while(0)
  #define ENDW(tt) do{ if((tt)+3<NT){WAIT_BAR(2);} else if((tt)+2<NT){WAIT_BAR(1);} else {WAIT_BAR(0);} }while(0)
  for(;t+1<NT;t+=2){
    STEP(pB0,pB1,pA0,pA1,t,(t+3<NT),(t+1<NT),(t+1<NT));       ENDW(t);   RESC(); ROT();
    STEP(pA0,pA1,pB0,pB1,t+1,(t+4<NT),(t+2<NT),(t+2<NT));     ENDW(t+1); RESC(); ROT();
  }
  STEP(pB0,pB1,pA0,pA1,NT-1,false,false,false); RESC();
  { float sacc=pB0[0]+pB0[1]; _Pragma("unroll") for(int r=2;r<16;++r)sacc+=pB0[r]; _Pragma("unroll") for(int r=0;r<16;++r)sacc+=pB1[r]; l_reg+=sacc;
    pw0=(u32x4){PKW(pB0,0),PKW(pB0,2),PKW(pB0,4),PKW(pB0,6)};pw1=(u32x4){PKW(pB0,8),PKW(pB0,10),PKW(pB0,12),PKW(pB0,14)};pw2=(u32x4){PKW(pB1,0),PKW(pB1,2),PKW(pB1,4),PKW(pB1,6)};pw3=(u32x4){PKW(pB1,8),PKW(pB1,10),PKW(pB1,12),PKW(pB1,14)};
    SBAR(); pv(o,vb0+sl_cur,PAF(0),PAF(1),PAF(2),PAF(3)); }
  #undef PKW
  #undef PAF
  #undef VFR
  #undef PIN
  #undef MX3
  #undef GAPA
  #undef GAPB
  #undef EX
  #undef VRD
  #undef KRD
  #undef STEP
  #undef ENDW
  {auto rr=__builtin_amdgcn_permlane32_swap(__float_as_uint(l_reg),__float_as_uint(l_reg),false,false);l_reg=__uint_as_float(rr[0])+__uint_as_float(rr[1]);}
  if(hi==0)wsf[32+r32]=l_reg;asm volatile("s_waitcnt lgkmcnt(0)":::"memory");
  float rli[16];
  #pragma unroll
  for(int r=0;r<16;++r)rli[r]=__builtin_amdgcn_rcpf(wsf[32+crow(r,hi)]);
  bf16*Ow=O+(rowbase+q0+wid*QBLK)*DM+hv*D;
  { bf16*stg=(bf16*)(shm+LDS_OST)+wid*2048;
    #pragma unroll
    for(int r=0;r<16;++r){const int orow=crow(r,hi);
      #pragma unroll
      for(int d0=0;d0<2;++d0)stg[orow*64+d0*32+r32]=__float2bfloat16(o[d0][r]*rli[r]);}
    asm volatile("s_waitcnt lgkmcnt(0)":::"memory");
    #pragma unroll
    for(int i=0;i<4;++i){const int row=i*8+(lane>>3),ch=lane&7; const u32x4 v=*(const u32x4*)(stg+row*64+ch*8); ATTN_STORE16(Ow+(long)row*DM+ch*8,v);} }
  asm volatile("s_waitcnt lgkmcnt(0)\n\ts_barrier":::"memory");
  #undef DMA_K
  #undef DMA_V
  #undef CMASK
  #undef START
  #undef RESC
  #undef ROT
}
constexpr int ATTN_LDS_BYTES=LDS_BYTES;
struct AttnTensors { const bf16* Q; const bf16* K; const bf16* V; bf16* O0; bf16* O1; };
struct AttnUnit { int b, hq, hv, m, qb; };
struct StaticOrder {
  int bx, G;
  __device__ __forceinline__ explicit StaticOrder(int grid,int block):bx(block),G(grid){}
  __device__ __forceinline__ bool next(int i,AttnUnit&u)const{
    int bh,sub,qb;
    if(G==256){ if(i>=8)return false; const int x=bx&7,j=bx>>3,s=j&7; bh=x*4+(i>>1); sub=j>>3; qb=(i&1)?15-s:s; }
    else { const int U=i*G+bx; if(U>=2048)return false; bh=U>>6; sub=(U>>4)&3; qb=15-(U&15); }
    u.b=bh>>3; const int h=bh&7; u.m=sub>>1; u.hq=h*2+u.m; u.hv=h*2+(sub&1); u.qb=qb; return true; }
  __device__ __forceinline__ void a_ready(const AttnUnit&)const{}
  __device__ __forceinline__ void done(const AttnUnit&)const{}
};
template<class Sched,int THRL=8> __device__ __forceinline__ void attn_phase(char*lds,const AttnTensors&T,const Sched&S){
  AttnUnit u;
  for(int i=0;S.next(i,u);++i){ S.a_ready(u); attn_unit<THRL>(u.b,u.hq,u.hv,u.qb,T.Q,T.K,T.V,u.m?T.O1:T.O0,lds); S.done(u); }
}
#undef SBAR
#undef WAIT_BAR
}
namespace attn2 {
using bf16 = __hip_bfloat16;
typedef short bf16x8 __attribute__((ext_vector_type(8)));
typedef short s16x4 __attribute__((ext_vector_type(4)));
typedef float f32x16 __attribute__((ext_vector_type(16)));
typedef unsigned u32x4 __attribute__((ext_vector_type(4)));
constexpr int SEQ = 4096, DK = 64, DV = 128, PITCH = 1024;
constexpr float SCALE = 0.125f, THR = 8.f;
constexpr int NW = 8, QBLK = 32, KVBLK = 64, QB = NW * QBLK;
constexpr int SHM_V = KVBLK * DV * 2, SHM_K = KVBLK * DK * 2;
constexpr int LDS_BYTES = 2 * SHM_V + 2 * SHM_K + NW * 64 * 4;
#define A2_KSWZ(row, colB) ((row) * 128 + ((colB) ^ ((((row) >> 1) & 7) << 4)))
#define A2_SBAR() __builtin_amdgcn_sched_barrier(0)
__device__ __forceinline__ int v_st(int k, int c) { const int kk = (k & ~0xC) | ((k & 4) << 1) | ((k & 8) >> 1); return ((kk >> 3) * 4 + (c >> 5)) * 512 + ((kk & 7) * 32 + (c & 31)) * 2; }
__device__ __forceinline__ int v_rd_base(int lane) { return ((lane & 3) << 3) | (((lane >> 2) & 3) << 6) | (((lane >> 4) & 1) << 5) | (((lane >> 5) & 1) << 8); }
constexpr int v_rd_off(int d0, int ks, int half) { return d0 * 512 + ks * 4096 + half * 2048; }
__device__ __forceinline__ int crow(int r, int hi) { return (r & 3) + 8 * (r >> 2) + 4 * hi; }
__device__ __forceinline__ unsigned cvtpk(float lo, float hi) { unsigned r; asm("v_cvt_pk_bf16_f32 %0, %1, %2" : "=v"(r) : "v"(lo), "v"(hi)); return r; }
__device__ __forceinline__ bf16x8 load8(const bf16* p) { return *reinterpret_cast<const bf16x8*>(p); }
__device__ __forceinline__ void mask_tile(f32x16& p0, f32x16& p1, int dq) {
    const float NEG = -__builtin_inff();
#pragma unroll
    for (int r = 0; r < 16; ++r) { const int c = (r & 3) + 8 * (r >> 2);
        if (dq - c < 0) p0[r] = NEG;
        if (dq - c - 32 < 0) p1[r] = NEG; }
}
constexpr float THR2 = THR * 1.4426950408889634f;
__device__ __forceinline__ float max3f(float a, float b, float c) { float r; asm("v_max3_f32 %0, %1, %2, %3" : "=v"(r) : "v"(a), "v"(b), "v"(c)); return r; }
__device__ __forceinline__ float max2f(float a, float b) { float r; asm("v_max_f32_e32 %0, %1, %2" : "=v"(r) : "v"(a), "v"(b)); return r; }
__device__ __forceinline__ float max16f(const f32x16& p) {
    float a = max3f(p[0], p[1], p[2]), b = max3f(p[3], p[4], p[5]);
    a = max3f(a, p[6], p[7]); b = max3f(b, p[8], p[9]); a = max3f(a, p[10], p[11]); b = max3f(b, p[12], p[13]);
    return max3f(a, b, max2f(p[14], p[15]));
}
__device__ __forceinline__ float rowmax32_c(const f32x16& p0, const f32x16& p1) {
    float pmax = p0[0]; for (int r = 1; r < 16; ++r) pmax = fmaxf(pmax, p0[r]); for (int r = 0; r < 16; ++r) pmax = fmaxf(pmax, p1[r]);
    auto rr = __builtin_amdgcn_permlane32_swap(__float_as_uint(pmax), __float_as_uint(pmax), false, false);
    return fmaxf(__uint_as_float(rr[0]), __uint_as_float(rr[1]));
}
__device__ __forceinline__ float rowmax32(const f32x16& p0, const f32x16& p1) {
    const float pmax = max2f(max16f(p0), max16f(p1));
    auto rr = __builtin_amdgcn_permlane32_swap(__float_as_uint(pmax), __float_as_uint(pmax), false, false);
    return max2f(__uint_as_float(rr[0]), __uint_as_float(rr[1]));
}
__device__ __forceinline__ void partialSM_first(f32x16& p0, f32x16& p1, f32x16& negm, float& alpha) {
    const float pmax = rowmax32_c(p0, p1);
    for (int r = 0; r < 16; ++r) { p0[r] -= pmax; p1[r] -= pmax; }
    for (int r = 0; r < 16; ++r) negm[r] = -pmax;
    asm volatile("" : "+v"(negm));
    alpha = 1.f;
    for (int r = 0; r < 16; ++r) p0[r] = __builtin_amdgcn_exp2f(p0[r]);
}
__device__ __forceinline__ void psm_decide(f32x16& p0, f32x16& p1, f32x16& negm, float pmax, float& alpha) {
    if (__builtin_expect(__all(pmax <= THR2), 1)) { alpha = 1.f; }
    else { const float dl = max2f(pmax, 0.f); alpha = __builtin_amdgcn_exp2f(-dl);
        for (int r = 0; r < 16; ++r) { p0[r] -= dl; p1[r] -= dl; }
        for (int r = 0; r < 16; ++r) negm[r] -= dl;
        asm volatile("" : "+v"(negm)); }
}
__device__ __forceinline__ void partialSM_n(f32x16& p0, f32x16& p1, f32x16& negm, float& alpha) {
    psm_decide(p0, p1, negm, rowmax32(p0, p1), alpha);
    for (int r = 0; r < 16; ++r) p0[r] = __builtin_amdgcn_exp2f(p0[r]);
}
__device__ __forceinline__ void finishSM(f32x16& p0, f32x16& p1, float alpha, float& l_reg, bf16x8& pa0, bf16x8& pa1, bf16x8& pa2, bf16x8& pa3) {
    for (int r = 0; r < 16; ++r) p1[r] = __builtin_amdgcn_exp2f(p1[r]);
    float ps = 0; for (int r = 0; r < 16; ++r) ps += p0[r]; for (int r = 0; r < 16; ++r) ps += p1[r];
    { auto rr = __builtin_amdgcn_permlane32_swap(__float_as_uint(ps), __float_as_uint(ps), false, false);
      ps = __uint_as_float(rr[0]) + __uint_as_float(rr[1]); }
    l_reg = l_reg * alpha + ps;
#define A2_PK4(P, B_, OUT) do { unsigned a0 = cvtpk(P[B_+0], P[B_+1]), a1 = cvtpk(P[B_+2], P[B_+3]);                          \
        unsigned b0 = cvtpk(P[B_+4], P[B_+5]), b1 = cvtpk(P[B_+6], P[B_+7]);                                             \
        auto r0 = __builtin_amdgcn_permlane32_swap(a0, b0, false, false); auto r1 = __builtin_amdgcn_permlane32_swap(a1, b1, false, false); \
        u32x4 w = {r0[0], r1[0], r0[1], r1[1]}; OUT = *reinterpret_cast<bf16x8*>(&w); } while (0)
    A2_PK4(p0, 0, pa0); A2_PK4(p0, 8, pa1); A2_PK4(p1, 0, pa2); A2_PK4(p1, 8, pa3);
#undef A2_PK4
}
template <int KB>
__device__ __forceinline__ void qkt(f32x16& p0, f32x16& p1, const char* K_lds, int r32, int hi, const bf16x8* qr, const f32x16& cinit) {
    p0 = cinit; p1 = cinit;
#pragma unroll
    for (int d0 = 0; d0 < 4; ++d0) { const char* a = K_lds + KB * SHM_K + A2_KSWZ(r32, (d0 * 16 + hi * 8) * 2);
        bf16x8 b0 = *reinterpret_cast<const bf16x8*>(a);
        bf16x8 b1 = *reinterpret_cast<const bf16x8*>(a + 32 * 128);
        p0 = __builtin_amdgcn_mfma_f32_32x32x16_bf16(b0, qr[d0], p0, 0, 0, 0);
        p1 = __builtin_amdgcn_mfma_f32_32x32x16_bf16(b1, qr[d0], p1, 0, 0, 0); }
}
template <int VB>
__device__ __forceinline__ void pv_tile(f32x16* o, int vb0, bf16x8 pa0, bf16x8 pa1, bf16x8 pa2, bf16x8 pa3) {
#define A2_TRRD(dst, off) asm volatile("ds_read_b64_tr_b16 %0, %1 offset:%2" : "=&v"(dst) : "v"(vb0), "i"(off) : "memory")
#define A2_PV_D0(ks) do { s16x4 l0, l1, l2, l3, h0, h1, h2, h3; constexpr int b_ = VB * SHM_V + v_rd_off(0, ks, 0);     \
        A2_TRRD(l0, b_); A2_TRRD(h0, b_ + 2048); A2_TRRD(l1, b_ + 512); A2_TRRD(h1, b_ + 512 + 2048); A2_TRRD(l2, b_ + 1024); A2_TRRD(h2, b_ + 1024 + 2048); A2_TRRD(l3, b_ + 1536); A2_TRRD(h3, b_ + 1536 + 2048); \
        asm volatile("s_waitcnt lgkmcnt(0)" ::: "memory"); A2_SBAR();   \
        { const bf16x8 pk_ = (ks) == 0 ? pa0 : (ks) == 1 ? pa1 : (ks) == 2 ? pa2 : pa3;     \
        o[0] = __builtin_amdgcn_mfma_f32_32x32x16_bf16(pk_, (bf16x8){l0[0], l0[1], l0[2], l0[3], h0[0], h0[1], h0[2], h0[3]}, o[0], 0, 0, 0);   \
        o[1] = __builtin_amdgcn_mfma_f32_32x32x16_bf16(pk_, (bf16x8){l1[0], l1[1], l1[2], l1[3], h1[0], h1[1], h1[2], h1[3]}, o[1], 0, 0, 0);   \
        o[2] = __builtin_amdgcn_mfma_f32_32x32x16_bf16(pk_, (bf16x8){l2[0], l2[1], l2[2], l2[3], h2[0], h2[1], h2[2], h2[3]}, o[2], 0, 0, 0);   \
        o[3] = __builtin_amdgcn_mfma_f32_32x32x16_bf16(pk_, (bf16x8){l3[0], l3[1], l3[2], l3[3], h3[0], h3[1], h3[2], h3[3]}, o[3], 0, 0, 0); } } while (0)
    A2_PV_D0(0); A2_PV_D0(1); A2_PV_D0(2); A2_PV_D0(3);
#undef A2_PV_D0
#undef A2_TRRD
}
template <int VB>
__device__ __forceinline__ void pv_psm(f32x16* o, int vb0, bf16x8 pa0, bf16x8 pa1, bf16x8 pa2, bf16x8 pa3, f32x16& p0, f32x16& p1, f32x16& negm, float& alpha) {
#define A2_TRRD(dst, off) asm volatile("ds_read_b64_tr_b16 %0, %1 offset:%2" : "=&v"(dst) : "v"(vb0), "i"(off) : "memory")
#define A2_PV_D0(ks) do { s16x4 l0, l1, l2, l3, h0, h1, h2, h3; constexpr int b_ = VB * SHM_V + v_rd_off(0, ks, 0);     \
        A2_TRRD(l0, b_); A2_TRRD(h0, b_ + 2048); A2_TRRD(l1, b_ + 512); A2_TRRD(h1, b_ + 512 + 2048); A2_TRRD(l2, b_ + 1024); A2_TRRD(h2, b_ + 1024 + 2048); A2_TRRD(l3, b_ + 1536); A2_TRRD(h3, b_ + 1536 + 2048); \
        asm volatile("s_waitcnt lgkmcnt(0)" ::: "memory"); A2_SBAR();   \
        { const bf16x8 pk_ = (ks) == 0 ? pa0 : (ks) == 1 ? pa1 : (ks) == 2 ? pa2 : pa3;     \
        o[0] = __builtin_amdgcn_mfma_f32_32x32x16_bf16(pk_, (bf16x8){l0[0], l0[1], l0[2], l0[3], h0[0], h0[1], h0[2], h0[3]}, o[0], 0, 0, 0);   \
        o[1] = __builtin_amdgcn_mfma_f32_32x32x16_bf16(pk_, (bf16x8){l1[0], l1[1], l1[2], l1[3], h1[0], h1[1], h1[2], h1[3]}, o[1], 0, 0, 0);   \
        o[2] = __builtin_amdgcn_mfma_f32_32x32x16_bf16(pk_, (bf16x8){l2[0], l2[1], l2[2], l2[3], h2[0], h2[1], h2[2], h2[3]}, o[2], 0, 0, 0);   \
        o[3] = __builtin_amdgcn_mfma_f32_32x32x16_bf16(pk_, (bf16x8){l3[0], l3[1], l3[2], l3[3], h3[0], h3[1], h3[2], h3[3]}, o[3], 0, 0, 0); } } while (0)
    A2_PV_D0(0);
    float pmax = max16f(p0);
    A2_PV_D0(1);
    pmax = max2f(pmax, max16f(p1));
    { auto rr = __builtin_amdgcn_permlane32_swap(__float_as_uint(pmax), __float_as_uint(pmax), false, false);
      pmax = max2f(__uint_as_float(rr[0]), __uint_as_float(rr[1])); }
    psm_decide(p0, p1, negm, pmax, alpha);
    A2_PV_D0(2);
    for (int r = 0; r < 8; ++r) p0[r] = __builtin_amdgcn_exp2f(p0[r]);
    asm volatile("" : "+v"(p0));
    A2_PV_D0(3);
    for (int r = 8; r < 16; ++r) p0[r] = __builtin_amdgcn_exp2f(p0[r]);
    asm volatile("" : "+v"(p0));
#undef A2_PV_D0
#undef A2_TRRD
}
struct BlockRef { const bf16* Q; const bf16* K; const bf16* V; bf16* O; int P0; };
struct Seam { bf16x8 qr[4]; bf16x8 st_v0, st_v1, st_k0; };
#define A2_VMW() asm volatile("s_waitcnt vmcnt(0)" ::: "memory")
#define A2_VMWN(n) asm volatile("s_waitcnt vmcnt(%0)" :: "i"(n) : "memory")
#define A2_SLOAD(Kp, Vp, k0) do { S.st_v0 = load8((Vp) + (size_t)((k0) + vsr) * PITCH + vsc); S.st_v1 = load8((Vp) + (size_t)((k0) + 32 + vsr) * PITCH + vsc); \
                                  S.st_k0 = load8((Kp) + (size_t)((k0) + ksr) * PITCH + ksc); } while (0)
#define A2_SWRITE_K(bf) do { *(bf16x8*)(K_lds + (bf) * SHM_K + kws) = S.st_k0; } while (0)
#define A2_SWRITE_V(bf) do { *(bf16x8*)(V_lds + (bf) * SHM_V + vst0) = S.st_v0; *(bf16x8*)(V_lds + (bf) * SHM_V + vst1) = S.st_v1; } while (0)
__device__ __forceinline__ void prime(const BlockRef& cur, char* lds, Seam& S) {
    int tid_ = threadIdx.x; asm volatile("" : "+v"(tid_));
    const int tid = tid_, wid = __builtin_amdgcn_readfirstlane(tid >> 6), lane = tid & 63, r32 = lane & 31, hi = lane >> 5;
    const int vsr = tid >> 4, vsc = (tid & 15) * 8, ksr = tid >> 3, ksc = (tid & 7) * 8, kws = A2_KSWZ(ksr, ksc * 2); char* K_lds = lds + 2 * SHM_V;
#pragma unroll
    for (int d0 = 0; d0 < 4; ++d0) S.qr[d0] = load8(cur.Q + (size_t)(wid * QBLK + r32) * PITCH + d0 * 16 + hi * 8);
    A2_SLOAD(cur.K, cur.V, 0); A2_VMW(); A2_SWRITE_K(0);
    __syncthreads();
}
__device__ __forceinline__ void block(const BlockRef& cur, const BlockRef& nxt, char* lds, Seam& S) {
    int tid_ = threadIdx.x; asm volatile("" : "+v"(tid_));
    const int tid = tid_, wid = __builtin_amdgcn_readfirstlane(tid >> 6), lane = tid & 63, r32 = lane & 31, hi = lane >> 5;
    const int NT = (cur.P0 + QB) / KVBLK;
    const int qe = (cur.P0 + wid * QBLK) | 63, qm = qe - 4 * hi;
    char* V_lds = lds; char* K_lds = lds + 2 * SHM_V;
    float* ws = (float*)(lds + 2 * SHM_V + 2 * SHM_K) + wid * 64; float* li_l = ws, * al_l = ws + 32;
    float l_reg = 0; f32x16 o[4] = {}; f32x16 negm = {};
    const int vsr = tid >> 4, vsc = (tid & 15) * 8, vst0 = v_st(vsr, vsc), vst1 = v_st(32 + vsr, vsc), ksr = tid >> 3, ksc = (tid & 7) * 8, kws = A2_KSWZ(ksr, ksc * 2);
    const int vb0 = (int)(uintptr_t)V_lds + v_rd_base(lane);
    const bf16* kq = cur.K + (size_t)(KVBLK + ksr) * PITCH + ksc; const bf16* vq0 = cur.V + (size_t)(KVBLK + vsr) * PITCH + vsc; const bf16* vq1 = vq0 + (size_t)32 * PITCH;
#define A2_SLOADN() do { S.st_v0 = load8(vq0); S.st_v1 = load8(vq1); S.st_k0 = load8(kq); vq0 += (size_t)KVBLK * PITCH; vq1 += (size_t)KVBLK * PITCH; kq += (size_t)KVBLK * PITCH; } while (0)
#define A2_RESC(a) do { if (__any((a) < 1.f)) { if (hi == 0) al_l[r32] = (a); asm volatile("s_waitcnt lgkmcnt(0)" ::: "memory");              \
                     for (int d_ = 0; d_ < 4; ++d_) for (int r = 0; r < 16; ++r) o[d_][r] *= al_l[crow(r, hi)]; } } while (0)
#define A2_KBASE(t) ((t) * KVBLK)
#define A2_MASKT(P0_, P1_, t) do { const int kb_ = A2_KBASE(t); if (kb_ + KVBLK - 1 > qe) mask_tile(P0_, P1_, qm - kb_); } while (0)
    constexpr int NQL = 4;
#define A2_SEAM_K0() do { A2_VMWN(NQL); A2_SWRITE_K(0); A2_SBAR(); } while (0)
    f32x16 pA0, pA1, pB0, pB1; float alA, alB; bf16x8 pa0, pa1, pa2, pa3;
    A2_SWRITE_V(0); A2_SBAR();
    if (NT > 1) A2_SLOADN();
    A2_SBAR(); qkt<0>(pA0, pA1, K_lds, r32, hi, S.qr, negm);
    partialSM_first(pA0, pA1, negm, alA);
    if (NT > 1) { A2_VMW(); A2_SWRITE_V(1); A2_SWRITE_K(1); }
    __syncthreads();
#define A2_HALF_STEP(PX0, PX1, alX, PY0, PY1, alY, t, KB, VB, SB) do {                                                      \
        A2_SBAR(); if ((t) + 1 < NT) { A2_SLOADN(); A2_SBAR(); }     \
        qkt<KB>(PX0, PX1, K_lds, r32, hi, S.qr, negm);                                                                               \
        finishSM(PY0, PY1, alY, l_reg, pa0, pa1, pa2, pa3); A2_SBAR();                                                           \
        A2_MASKT(PX0, PX1, (t)); pv_psm<VB>(o, vb0, pa0, pa1, pa2, pa3, PX0, PX1, negm, alX);                              \
        __syncthreads();                                                                                                      \
        if ((t) + 1 < NT) { A2_VMW(); A2_SWRITE_V(SB); A2_SWRITE_K(SB); }                                                      \
        A2_RESC(alX); __syncthreads(); } while (0)
    for (int t = 1; t + 1 < NT; t += 2) {
        A2_HALF_STEP(pB0, pB1, alB, pA0, pA1, alA, t, 1, 0, 0);
        A2_HALF_STEP(pA0, pA1, alA, pB0, pB1, alB, t + 1, 0, 1, 1);
    }
    A2_SBAR(); qkt<1>(pB0, pB1, K_lds, r32, hi, S.qr, negm); A2_SBAR();
    A2_SLOAD(nxt.K, nxt.V, 0); A2_SBAR();
#pragma unroll
    for (int d0 = 0; d0 < 4; ++d0) S.qr[d0] = load8(nxt.Q + (size_t)(wid * QBLK + r32) * PITCH + d0 * 16 + hi * 8);
    A2_SBAR();
    finishSM(pA0, pA1, alA, l_reg, pa0, pa1, pa2, pa3); A2_SBAR();
    pv_tile<0>(o, vb0, pa0, pa1, pa2, pa3);
    A2_MASKT(pB0, pB1, NT - 1); partialSM_n(pB0, pB1, negm, alB); __syncthreads(); A2_RESC(alB);
    finishSM(pB0, pB1, alB, l_reg, pa0, pa1, pa2, pa3); A2_SBAR(); pv_tile<1>(o, vb0, pa0, pa1, pa2, pa3);
    A2_SBAR(); A2_SEAM_K0();
    if (hi == 0) li_l[r32] = l_reg; asm volatile("s_waitcnt lgkmcnt(0)" ::: "memory");
    float rli[16];
#pragma unroll
    for (int r = 0; r < 16; ++r) rli[r] = __builtin_amdgcn_rcpf(li_l[crow(r, hi)]);
    bf16* Ow = cur.O + (size_t)(wid * QBLK) * PITCH;
#pragma unroll
    for (int r = 0; r < 16; ++r) { const int orow = crow(r, hi);
#pragma unroll
        for (int d0 = 0; d0 < 4; ++d0) { const float v = o[d0][r] * rli[r];
            const float vn = __shfl_xor(v, 1);
            if ((r32 & 1) == 0) *(unsigned*)(Ow + (size_t)orow * PITCH + d0 * 32 + r32) = cvtpk(v, vn); } }
    __syncthreads();
#undef A2_RESC
#undef A2_KBASE
#undef A2_MASKT
#undef A2_SEAM_K0
#undef A2_HALF_STEP
#undef A2_SLOADN
}
#undef A2_VMW
#undef A2_VMWN
#undef A2_SLOAD
#undef A2_SWRITE_K
#undef A2_SWRITE_V
struct Tensors { const bf16* Q; const bf16* K; const bf16* V; bf16* O0; bf16* O1; };
__device__ __forceinline__ bool item(int i, int G, int bx, int& triple, int& qb) {
    if (G == 256) { if (i >= 4) return false; const int x = bx & 7, j = bx >> 3, s = j & 7, k = i >> 1; triple = 8 * x + 4 * k + (j >> 3); qb = (i & 1) ? 15 - s : s; return true; }
    const int U = i * G + bx; if (U >= 1024) return false; triple = U >> 4; qb = 15 - (U & 15); return true;
}
__device__ __forceinline__ BlockRef ref(const Tensors& T, int triple, int qb) {
    const int bh = triple >> 1, m = triple & 1, b = bh >> 3, h = bh & 7; const size_t row0 = (size_t)b * SEQ;
    BlockRef r; r.Q = T.Q + (row0 + (size_t)qb * QB) * PITCH + (h * 2 + m) * DK; r.K = T.K + row0 * PITCH + (h * 2 + m) * DK; r.V = T.V + row0 * PITCH + h * DV;
    r.O = (m ? T.O1 : T.O0) + (row0 + (size_t)qb * QB) * PITCH + h * DV; r.P0 = qb * QB; return r;
}
__device__ __forceinline__ void phase(char* lds, const Tensors& T, int G, int bx) {
    int triple, qb; if (!item(0, G, bx, triple, qb)) return;
    BlockRef cur = ref(T, triple, qb);
    Seam S; prime(cur, lds, S);
    for (int i = 0;; ++i) {
        int tn, qn; const bool more = item(i + 1, G, bx, tn, qn);
        const BlockRef nxt = more ? ref(T, tn, qn) : cur;
        block(cur, nxt, lds, S);
        if (!more) break;
        cur = nxt;
    }
}
#undef A2_KSWZ
#undef A2_SBAR
}

namespace cg = cooperative_groups;
constexpr int NWAVES = 8;
#ifndef ATTN_V128
#define ATTN_V128 1
#endif
#ifndef MK_MULTI
#define MK_MULTI 0
#endif
constexpr int NB = 4, S = 4096, D = 2048, DEPTH = 4, M = NB * S, DIN = 6144, NHEADS = 8;
constexpr float EPS = 1e-6f;
constexpr int N_PHASES = 2 + 5 * DEPTH;
constexpr size_t MiB = 1u << 20;
constexpr size_t WS_WIN = 2 * MiB;
constexpr size_t WS_WOUT = 98 * MiB;
constexpr size_t WS_WPOOL = 130 * MiB;
constexpr size_t WS_H = 132 * MiB;
constexpr size_t WS_Z = 196 * MiB;
constexpr size_t WS_O = 388 * MiB;
constexpr size_t WS_POOLED = 452 * MiB;
constexpr size_t WS_MIX = 484 * MiB;
constexpr size_t WS_Y = 548 * MiB;
constexpr size_t WS_ADA = 612 * MiB;
constexpr size_t WS_ROPE = 620 * MiB;
constexpr size_t WS_X16 = 624 * MiB;
constexpr size_t WS_END = 688 * MiB;
constexpr size_t ZSTRIDE = (size_t)M * 1024;
constexpr int ADA_KS = 16;
constexpr int RING_BYTES = 131072, LDS_BYTES = 147456, MISC_OFF = RING_BYTES + 320;
constexpr size_t WS_CTL = 0, CTL_ZERO_BYTES = 65536; constexpr int CW_BAR = 4096;

#define LAS __attribute__((address_space(3)))
typedef unsigned short bf16;
typedef unsigned v4u __attribute__((ext_vector_type(4)));
typedef unsigned v2u __attribute__((ext_vector_type(2)));
typedef float f32x4 __attribute__((ext_vector_type(4)));
#define LDS_WAIT() asm volatile("s_waitcnt lgkmcnt(0)" ::: "memory")
__device__ __forceinline__ unsigned f2bf(float f) { unsigned u = __builtin_bit_cast(unsigned, f); return (u + 0x7fffu + ((u >> 16) & 1u)) >> 16; }
__device__ __forceinline__ unsigned pk2(float lo, float hi) { return f2bf(lo) | (f2bf(hi) << 16); }
__device__ __forceinline__ float wave_sum(float v) {
#pragma unroll
    for (int o = 1; o < 64; o <<= 1) v += __shfl_xor(v, o);
    return v;
}

struct Frame { LAS unsigned char* lds; int tid, lane, wave, vcu, G; };
__device__ __forceinline__ Frame make_frame(unsigned char* lds_generic) {
    Frame F; F.lds = (LAS unsigned char*)lds_generic;
    int tid = threadIdx.x; asm volatile("" : "+v"(tid)); int bx = blockIdx.x; asm volatile("" : "+s"(bx)); int G = gridDim.x; asm volatile("" : "+s"(G));
    F.tid = tid; F.lane = tid & 63; F.wave = __builtin_amdgcn_readfirstlane(tid >> 6); F.G = G; F.vcu = (G % 8 == 0) ? (bx % 8) * (G / 8) + bx / 8 : bx;
    return F;
}
typedef const unsigned char __attribute__((address_space(4)))* kptr_t;
__device__ __forceinline__ int opaque_bx() { int bx = blockIdx.x; asm volatile("" : "+s"(bx)); return bx; }
__device__ __forceinline__ int opaque_G() { int G = gridDim.x; asm volatile("" : "+s"(G)); return G; }
__device__ __forceinline__ kptr_t kargs_opaque() { kptr_t p = (kptr_t)__builtin_amdgcn_kernarg_segment_ptr(); asm volatile("" : "+s"(p)); return p; }
template <class T> __device__ __forceinline__ T* karg(kptr_t kp, int idx) { return *(T* const __attribute__((address_space(4)))*)(kp + 8 * idx); }
enum { A_X = 0, A_C, A_POS, A_WADA, A_BADA, A_GPRE, A_WIN, A_WPOOL, A_PSCALE, A_LQ1, A_LK1, A_LQ2, A_LK2, A_SUBLN, A_WOUT, A_GPOST, A_OUT, A_WS };
#define WSP(T, off) ((T*)(karg<unsigned char>(kp, A_WS) + (off)))

__device__ __forceinline__ int inmap(int n) { if (n < 2048 || n >= 4096) return n; const int p = n & 63, g = p >> 3, j = p & 7; return (n & ~63) + ((j < 4) ? 4 * g + j : 32 + 4 * g + (j - 4)); }

struct TItem { const float* src; size_t nstride; bf16* dst; int K; };
__device__ __forceinline__ TItem t_decode(int it, int lane, const float* w_in, const float* w_out, const float* w_pool, bf16* Win_t, bf16* Wout_t, bf16* Wpool_t) {
    constexpr int I_IN = (D / 64) * (DIN / 32), I_OUT = (D / 64) * (D / 32), I_PG = (256 / 64) * (256 / 32), I_LAYER = I_IN + I_OUT + 4 * I_PG;
    const int l = it / I_LAYER; int r = it % I_LAYER;
    const float* W; bf16* WT; int K, N; bool perm = false;
    if (r < I_IN) { W = w_in + (size_t)l * D * DIN; WT = Win_t + (size_t)l * DIN * D; K = D; N = DIN; perm = true; }
    else if (r < I_IN + I_OUT) { r -= I_IN; W = w_out + (size_t)l * D * D; WT = Wout_t + (size_t)l * D * D; K = D; N = D; }
    else { r -= I_IN + I_OUT; const int g = r / I_PG; r %= I_PG; W = w_pool + (size_t)(l * 4 + g) * 65536; WT = Wpool_t + (size_t)(l * 4 + g) * 65536; K = 256; N = 256; }
    const int nblk = N / 32, kb = r / nblk, nb = r % nblk, k0 = 64 * kb, n0 = 32 * nb;
    const int srcn = perm ? inmap(n0 + (lane & 31)) : n0 + (lane & 31);
    TItem t; t.src = W + (size_t)(k0 + (lane >> 5)) * N + srcn; t.nstride = (size_t)N; t.dst = WT + (size_t)n0 * K + k0; t.K = K; return t;
}
__device__ __forceinline__ void t_load(const TItem& t, float (&v)[32]) {
#pragma unroll
    for (int i = 0; i < 32; ++i) v[i] = t.src[(size_t)(2 * i) * t.nstride];
}
__device__ __forceinline__ void t_store(const TItem& t, const float (&v)[32], LAS float* scr, int lane) {
#pragma unroll
    for (int i = 0; i < 32; ++i) scr[(2 * i + (lane >> 5)) * 33 + (lane & 31)] = v[i];
    LDS_WAIT(); asm volatile("" ::: "memory");
    const int c = lane & 7;
#pragma unroll
    for (int j = 0; j < 4; ++j) { const int n = (lane >> 3) + 8 * j; const LAS float* s = scr + (8 * c) * 33 + n;
        v4u o; o.x = pk2(s[0 * 33], s[1 * 33]); o.y = pk2(s[2 * 33], s[3 * 33]); o.z = pk2(s[4 * 33], s[5 * 33]); o.w = pk2(s[6 * 33], s[7 * 33]);
        *(v4u*)(t.dst + (size_t)n * t.K + 8 * c) = o; }
    LDS_WAIT(); asm volatile("" ::: "memory");
}

__device__ __forceinline__ void phase_prologue(unsigned char* lds_) {
    Frame F = make_frame(lds_);
    const kptr_t kp = kargs_opaque();
    const float* w_in = karg<const float>(kp, A_WIN); const float* w_out = karg<const float>(kp, A_WOUT); const float* w_pool = karg<const float>(kp, A_WPOOL);
    bf16* Win_t = WSP(bf16, WS_WIN); bf16* Wout_t = WSP(bf16, WS_WOUT); bf16* Wpool_t = WSP(bf16, WS_WPOOL);
    LAS float* scr = (LAS float*)(F.lds + F.wave * 16384);
    const int gw = F.vcu * NWAVES + F.wave, NGW = F.G * NWAVES;
    {
        constexpr int I_LAYER = (D / 64) * (DIN / 32) + (D / 64) * (D / 32) + 4 * (256 / 64) * (256 / 32), NIT = DEPTH * I_LAYER;
        float va[32], vb[32];
        int it = gw;
        TItem ta = t_decode(it < NIT ? it : 0, F.lane, w_in, w_out, w_pool, Win_t, Wout_t, Wpool_t), tb = ta;
        if (it < NIT) t_load(ta, va);
        while (it < NIT) {
            const int it2 = it + NGW;
            if (it2 < NIT) { tb = t_decode(it2, F.lane, w_in, w_out, w_pool, Win_t, Wout_t, Wpool_t); t_load(tb, vb); }
            t_store(ta, va, scr, F.lane);
            if (it2 >= NIT) break;
            const int it3 = it2 + NGW;
            if (it3 < NIT) { ta = t_decode(it3, F.lane, w_in, w_out, w_pool, Win_t, Wout_t, Wpool_t); t_load(ta, va); }
            t_store(tb, vb, scr, F.lane);
            it = it3;
        }
    }
    constexpr int KSL = D / ADA_KS;
    const float* w_ada = karg<const float>(kp, A_WADA); const float* cvec = karg<const float>(kp, A_C); float* ADA = WSP(float, WS_ADA);
    for (int it = gw; it < DEPTH * ADA_KS * 24; it += NGW) {
        const int cb = it % 24, ks = (it / 24) % ADA_KS, l = it / (24 * ADA_KS);
        const float* w = w_ada + ((size_t)l * D + ks * KSL) * DIN + cb * 256 + F.lane * 4;
        const float* cc = cvec + ks * KSL;
        f32x4 a0 = {0.f, 0.f, 0.f, 0.f}, a1 = a0, a2 = a0, a3 = a0;
#pragma unroll 16
        for (int k = 0; k < KSL; ++k) { const f32x4 wv = *(const f32x4*)(w + (size_t)k * DIN);
            a0 += wv * cc[k]; a1 += wv * cc[D + k]; a2 += wv * cc[2 * D + k]; a3 += wv * cc[3 * D + k]; }
        float* o = ADA + ((size_t)(ks * DEPTH + l) * NB) * DIN + cb * 256 + F.lane * 4;
        *(f32x4*)(o) = a0; *(f32x4*)(o + DIN) = a1; *(f32x4*)(o + 2 * DIN) = a2; *(f32x4*)(o + 3 * DIN) = a3;
    }
    const int* pos = karg<const int>(kp, A_POS); float* COS = WSP(float, WS_ROPE); float* SIN = COS + (size_t)M * 32;
    for (int idx = F.vcu * 512 + F.tid; idx < M * 32; idx += F.G * 512) {
        const int t = idx >> 5, i = idx & 31;
        const float inv_freq = (float)exp2(-(double)i * (13.287712379549449 / 32.0));
        const float ang = (float)pos[t] * inv_freq;
        double rev = (double)ang * 0.15915494309189535; rev -= floor(rev);
        COS[idx] = __builtin_amdgcn_cosf((float)rev); SIN[idx] = __builtin_amdgcn_sinf((float)rev);
    }
}

#ifndef RP
#define RP 2
#endif
template <bool HAS_Y, bool HAS_H, bool XIN32, bool XOUT32>
__device__ __forceinline__ void phase_rowpass(unsigned char* lds_, int lpost, int lpre) {
    Frame F = make_frame(lds_);
    const kptr_t kp = kargs_opaque();
    float* xout = karg<float>(kp, A_OUT); const float* xin = karg<const float>(kp, A_X); bf16* X16 = WSP(bf16, WS_X16);
    const float* b_ada = karg<const float>(kp, A_BADA); const float* g_post = karg<const float>(kp, A_GPOST); const float* g_pre = karg<const float>(kp, A_GPRE);
    const float* ADA = WSP(const float, WS_ADA); const bf16* Y = WSP(const bf16, WS_Y); bf16* H = WSP(bf16, WS_H);
    LAS float* vA = (LAS float*)F.lds; LAS float* vB = vA + D; LAS float* vC = vB + D;
    for (int chunk = blockIdx.x; chunk < M / 64; chunk += F.G) {
        const int b = chunk >> 6;
        {
            const Frame Mf = make_frame(lds_); const unsigned j0 = (unsigned)Mf.tid * 4u;
            if (HAS_Y) { f32x4 g = *(const f32x4*)(b_ada + (size_t)lpost * DIN + 2 * D + j0);
                for (int ks = 0; ks < ADA_KS; ++ks) g += *(const f32x4*)(ADA + ((size_t)(ks * DEPTH + lpost) * NB + b) * DIN + 2 * D + j0);
                const f32x4 gp = *(const f32x4*)(g_post + (size_t)lpost * D + j0);
                *(LAS f32x4*)(vA + j0) = (g + 1.0f) * gp; }
            if (HAS_H) { f32x4 sh = *(const f32x4*)(b_ada + (size_t)lpre * DIN + j0), sc = *(const f32x4*)(b_ada + (size_t)lpre * DIN + D + j0);
                for (int ks = 0; ks < ADA_KS; ++ks) { const float* p = ADA + ((size_t)(ks * DEPTH + lpre) * NB + b) * DIN + j0; sh += *(const f32x4*)p; sc += *(const f32x4*)(p + D); }
                const f32x4 gp = *(const f32x4*)(g_pre + (size_t)lpre * D + j0);
                *(LAS f32x4*)(vB + j0) = (sc + 1.0f) * gp; *(LAS f32x4*)(vC + j0) = sh; }
        }
        __syncthreads();
        const Frame R = make_frame(lds_);
        const unsigned lo4 = (unsigned)R.lane * 4u;
        for (int i = 0; i < 8 / RP; ++i) {
            const size_t r0 = (size_t)chunk * 64 + R.wave * 8 + RP * i;
            f32x4 xv[RP][8]; v2u yw[RP][8];
#pragma unroll
            for (int p = 0; p < RP; ++p)
#pragma unroll
                for (int j = 0; j < 8; ++j) {
                    if (XIN32) xv[p][j] = *(const f32x4*)(xin + (r0 + p) * D + j * 256 + lo4);
                    else { const v2u w = *(const v2u*)(X16 + (r0 + p) * D + j * 256 + lo4);
                        xv[p][j] = (f32x4){__uint_as_float(w.x << 16), __uint_as_float(w.x & 0xffff0000u), __uint_as_float(w.y << 16), __uint_as_float(w.y & 0xffff0000u)}; }
                    if (HAS_Y) yw[p][j] = *(const v2u*)(Y + (r0 + p) * D + j * 256 + lo4); }
#pragma unroll
            for (int p = 0; p < RP; ++p) {
                const size_t r = r0 + p;
                if (HAS_Y) {
                    f32x4 yv[8]; float ss = 0.f;
#pragma unroll
                    for (int j = 0; j < 8; ++j) { const v2u w = yw[p][j];
                        yv[j] = (f32x4){__uint_as_float(w.x << 16), __uint_as_float(w.x & 0xffff0000u), __uint_as_float(w.y << 16), __uint_as_float(w.y & 0xffff0000u)};
                        ss += (yv[j].x * yv[j].x + yv[j].y * yv[j].y) + (yv[j].z * yv[j].z + yv[j].w * yv[j].w); }
                    const float ry = 1.0f / sqrtf(wave_sum(ss) * (1.0f / D) + EPS);
#pragma unroll
                    for (int j = 0; j < 8; ++j) { const f32x4 a = *(const LAS f32x4*)(vA + j * 256 + lo4); xv[p][j] += a * (yv[j] * ry);
                        if (XOUT32) *(f32x4*)(xout + r * D + j * 256 + lo4) = xv[p][j];
                        else { v2u w; w.x = pk2(xv[p][j].x, xv[p][j].y); w.y = pk2(xv[p][j].z, xv[p][j].w); *(v2u*)(X16 + r * D + j * 256 + lo4) = w; } }
                }
                if (HAS_H) {
                    float ss = 0.f;
#pragma unroll
                    for (int j = 0; j < 8; ++j) ss += (xv[p][j].x * xv[p][j].x + xv[p][j].y * xv[p][j].y) + (xv[p][j].z * xv[p][j].z + xv[p][j].w * xv[p][j].w);
                    const float rx = 1.0f / sqrtf(wave_sum(ss) * (1.0f / D) + EPS);
#pragma unroll
                    for (int j = 0; j < 8; ++j) { const f32x4 bb = *(const LAS f32x4*)(vB + j * 256 + lo4), cc = *(const LAS f32x4*)(vC + j * 256 + lo4);
                        const f32x4 h = (xv[p][j] * rx) * bb + cc; v2u w; w.x = pk2(h.x, h.y); w.y = pk2(h.z, h.w);
                        *(v2u*)(H + r * D + j * 256 + lo4) = w; }
                }
            }
        }
        __syncthreads();
    }
}

__device__ __forceinline__ void bf8_to_f32(const v4u v, float (&o)[8]) {
    o[0] = __uint_as_float(v.x << 16); o[1] = __uint_as_float(v.x & 0xffff0000u); o[2] = __uint_as_float(v.y << 16); o[3] = __uint_as_float(v.y & 0xffff0000u);
    o[4] = __uint_as_float(v.z << 16); o[5] = __uint_as_float(v.z & 0xffff0000u); o[6] = __uint_as_float(v.w << 16); o[7] = __uint_as_float(v.w & 0xffff0000u);
}
__device__ __forceinline__ void phase_pooled(unsigned char* lds_) {
    Frame F = make_frame(lds_);
    const kptr_t kp = kargs_opaque();
    const bf16* U = WSP(const bf16, WS_Z); bf16* POOLED = WSP(bf16, WS_POOLED);
    for (int item = F.vcu * 512 + F.tid; item < (M / 16) * 128; item += F.G * 512) {
        const int ch = item & 127, run = item >> 7, g = ch >> 5, w = 2 << g, t0 = run * 16, s0 = t0 & (S - 1);
        const bf16* up = U + (size_t)t0 * 1024 + ch * 8;
        v4u rows[31];
#pragma unroll
        for (int i = 0; i < 31; ++i) rows[i] = *(const v4u*)(up + (ptrdiff_t)(i - 15) * 1024);
        float s[8];
#pragma unroll
        for (int k = 0; k < 8; ++k) s[k] = 0.f;
#pragma unroll
        for (int i = 1; i < 16; ++i) { float a[8]; bf8_to_f32(rows[15 - i], a); const bool use = (i < w) && (s0 - i >= 0);
#pragma unroll
            for (int k = 0; k < 8; ++k) s[k] += use ? a[k] : 0.f; }
        bf16* op = POOLED + ((size_t)g * M + t0) * 256 + (ch & 31) * 8;
#pragma unroll
        for (int tt = 0; tt < 16; ++tt) {
            float cur[8]; bf8_to_f32(rows[15 + tt], cur);
            const int cnt = (s0 + tt + 1 < w) ? (s0 + tt + 1) : w; const float rc = 1.0f / (float)cnt;
            float o[8];
#pragma unroll
            for (int k = 0; k < 8; ++k) { s[k] += cur[k]; o[k] = s[k] * rc - cur[k]; }
            v4u ov; ov.x = pk2(o[0], o[1]); ov.y = pk2(o[2], o[3]); ov.z = pk2(o[4], o[5]); ov.w = pk2(o[6], o[7]);
            *(v4u*)(op + (size_t)tt * 256) = ov;
            float q2[8], q4[8], q8[8], q16[8]; bf8_to_f32(rows[15 + tt - 1], q2); bf8_to_f32(rows[15 + tt - 3], q4); bf8_to_f32(rows[15 + tt - 7], q8); bf8_to_f32(rows[15 + tt - 15], q16);
            const bool use = (s0 + tt - w + 1 >= 0);
#pragma unroll
            for (int k = 0; k < 8; ++k) { const float q = (g == 0) ? q2[k] : (g == 1) ? q4[k] : (g == 2) ? q8[k] : q16[k]; s[k] -= use ? q : 0.f; }
        }
    }
}

__device__ __forceinline__ void phase_diffcombine(unsigned char* lds_, int l) {
    Frame F = make_frame(lds_);
    const kptr_t kp = kargs_opaque();
    const float *lq1 = karg<const float>(kp, A_LQ1), *lk1 = karg<const float>(kp, A_LK1), *lq2 = karg<const float>(kp, A_LQ2), *lk2 = karg<const float>(kp, A_LK2), *subln_g = karg<const float>(kp, A_SUBLN);
    const float lam_init = 0.8f - 0.6f * expf(-0.3f * (float)l);
    const float d1 = wave_sum(lq1[l * 64 + F.lane] * lk1[l * 64 + F.lane]), d2 = wave_sum(lq2[l * 64 + F.lane] * lk2[l * 64 + F.lane]);
    const float lam = expf(d1) - expf(d2) + lam_init;
    const float post = 1.0f - lam_init;
    float gsub[16];
#pragma unroll
    for (int k = 0; k < 16; ++k) gsub[k] = subln_g[l * 128 + (F.lane & 7) * 16 + k] * post;
    const bf16 *O0 = WSP(const bf16, WS_O), *O1 = O0 + ZSTRIDE, *GD = WSP(const bf16, WS_Z) + 5 * ZSTRIDE; bf16* MIX = WSP(bf16, WS_MIX);
    const int gw = F.vcu * NWAVES + F.wave, NGW = F.G * NWAVES;
    const unsigned lo16 = (unsigned)F.lane * 16u;
    for (int rr = 2 * gw; rr < M; rr += 2 * NGW) {
        v4u pq[2][2], qq[2][2], gq[2][2];
#pragma unroll
        for (int p = 0; p < 2; ++p)
#pragma unroll
            for (int hh = 0; hh < 2; ++hh) { const size_t off = (size_t)(rr + p) * 1024 + hh * 8;
                pq[p][hh] = *(const v4u*)(O0 + off + lo16); qq[p][hh] = *(const v4u*)(O1 + off + lo16); gq[p][hh] = *(const v4u*)(GD + off + lo16); }
#pragma unroll
        for (int p = 0; p < 2; ++p) {
            float a[16]; float ss = 0.f;
#pragma unroll
            for (int hh = 0; hh < 2; ++hh) { float x0[8], x1[8]; bf8_to_f32(pq[p][hh], x0); bf8_to_f32(qq[p][hh], x1);
#pragma unroll
                for (int k = 0; k < 8; ++k) a[hh * 8 + k] = x0[k] - lam * x1[k]; }
#pragma unroll
            for (int k = 0; k < 16; ++k) ss += a[k] * a[k];
            ss += __shfl_xor(ss, 1); ss += __shfl_xor(ss, 2); ss += __shfl_xor(ss, 4);
            const float rn = 1.0f / sqrtf(ss * (1.0f / 128.0f) + EPS);
#pragma unroll
            for (int hh = 0; hh < 2; ++hh) { float gv[8], o[8]; bf8_to_f32(gq[p][hh], gv);
#pragma unroll
                for (int k = 0; k < 8; ++k) o[k] = a[hh * 8 + k] * rn * gsub[hh * 8 + k] * pg8::silu_f(gv[k]);
                v4u w; w.x = pk2(o[0], o[1]); w.y = pk2(o[2], o[3]); w.z = pk2(o[4], o[5]); w.w = pk2(o[6], o[7]);
                *(v4u*)(MIX + (size_t)(rr + p) * 2048 + 1024 + hh * 8 + lo16) = w; }
        }
    }
}

#define XB_TMO      128
#define XB_XCNT(j)  (256  + 64 * (j))
#define XB_XSUB(j)  (1280 + 64 * (j))
#define XB_XGEN(j)  (2304 + 64 * (j))
#define XB_TOP      3328
#define XB_TOPGEN   3392
#define XCD_BAR_WORDS 3456
#define XB_SPIN_CAP (1u << 18)

__device__ __forceinline__ unsigned xb_ld(unsigned* p)              { return __hip_atomic_load(p, __ATOMIC_RELAXED, __HIP_MEMORY_SCOPE_AGENT); }
__device__ __forceinline__ unsigned xb_add(unsigned* p, unsigned v) { return __hip_atomic_fetch_add(p, v, __ATOMIC_RELAXED, __HIP_MEMORY_SCOPE_AGENT); }
__device__ __forceinline__ unsigned xb_xcc_id() { return (unsigned)__builtin_amdgcn_s_getreg((3 << 11) | 20) & 0xFu; }
#define XB_SPIN(cond, bar) do { unsigned _sp = 0; while (cond) { __builtin_amdgcn_s_sleep(1); \
    if ((++_sp & 255u) == 0u) { if (xb_ld(&(bar)[XB_TMO])) break; if (_sp > XB_SPIN_CAP) { atomicAdd(&(bar)[XB_TMO], 1u); break; } } } } while (0)

struct XcdBarrier {
    unsigned* bar; unsigned x;
    volatile LAS unsigned* st;
};

__device__ __forceinline__ XcdBarrier xcd_barrier_post(unsigned* bar, volatile LAS unsigned* st) {
    XcdBarrier b; b.bar = bar; b.x = xb_xcc_id(); b.st = st;
    if (threadIdx.x == 0) (void)xb_add(&bar[XB_XCNT(b.x)], 1u);
    return b;
}
__device__ __forceinline__ void xcd_barrier_complete(unsigned* bar, unsigned x, unsigned& nloc, unsigned& nx) {
    const unsigned G = gridDim.x * gridDim.y * gridDim.z;
    unsigned sum, cnt, mine, sp = 0u;
    for (;;) {
        sum = 0u; cnt = 0u; mine = 0u;
#pragma unroll
        for (unsigned j = 0; j < 16; ++j) { const unsigned c = xb_ld(&bar[XB_XCNT(j)]); sum += c; cnt += (c > 0u) ? 1u : 0u; mine = (j == x) ? c : mine; }
        if (sum == G) break;
        __builtin_amdgcn_s_sleep(1);
        if ((++sp & 255u) == 0u) { if (xb_ld(&bar[XB_TMO])) break; if (sp > XB_SPIN_CAP) { atomicAdd(&bar[XB_TMO], 1u); break; } }
    }
    nloc = mine > 0u ? mine : 1u; nx = cnt > 0u ? cnt : 1u;
}

__device__ __forceinline__ void xcd_barrier(const XcdBarrier& b) {
    asm volatile("s_waitcnt vmcnt(0)" ::: "memory");
    __syncthreads();
    if (threadIdx.x == 0) {
        unsigned* bar = b.bar;
        __builtin_amdgcn_s_waitcnt(0);
        unsigned nloc = b.st[0], nx = b.st[1];
        if (nloc == 0u) { xcd_barrier_complete(bar, b.x, nloc, nx); b.st[0] = nloc; b.st[1] = nx; }
        const unsigned old = xb_add(&bar[XB_XSUB(b.x)], 1u);
        const unsigned gen = old / nloc;
        if (old + 1u == (gen + 1u) * nloc) {
            __builtin_amdgcn_fence(__ATOMIC_RELEASE, "agent");
            asm volatile("s_waitcnt vmcnt(0)" ::: "memory");
            const unsigned og = xb_add(&bar[XB_TOP], 1u);
            const unsigned tg = og / nx;
            if (og + 1u == (tg + 1u) * nx) xb_add(&bar[XB_TOPGEN], 1u);
            else XB_SPIN(xb_ld(&bar[XB_TOPGEN]) == tg, bar);
            __builtin_amdgcn_fence(__ATOMIC_ACQUIRE, "agent");
            xb_add(&bar[XB_XGEN(b.x)], 1u);
            asm volatile("s_waitcnt vmcnt(0)" ::: "memory");
        } else {
            XB_SPIN(xb_ld(&bar[XB_XGEN(b.x)]) == gen, bar);
            __builtin_amdgcn_fence(__ATOMIC_ACQUIRE, "agent");
            asm volatile("s_waitcnt vmcnt(0)" ::: "memory");
        }
    }
    __syncthreads();
}
struct Args { const void* in[16]; float* out; unsigned char* ws; int ph_lo, ph_hi; };
__global__ void __launch_bounds__(NWAVES * 64, 2) mega_fwd(Args args) {
    extern __shared__ __attribute__((aligned(16))) unsigned char lds[];
    cg::grid_group grid = cg::this_grid();
#if MK_MULTI
    const int lo = args.ph_lo, hi = args.ph_hi;
#define IN(k) (lo <= (k) && (k) < hi)
#define SEAM(k) do { if ((k) + 1 < hi) { grid.sync(); } } while (0)
#else
    if (threadIdx.x < 32) ((LAS unsigned*)((LAS unsigned char*)lds + MISC_OFF))[threadIdx.x] = 0u;
    __syncthreads();
    { const kptr_t kp = kargs_opaque(); (void)xcd_barrier_post(WSP(unsigned, WS_CTL) + CW_BAR, (volatile LAS unsigned*)((LAS unsigned char*)lds + MISC_OFF) + 8); }
#define IN(k) true
#define SEAM(k) do { if ((k) + 1 < N_PHASES) { if ((k) == 0) grid.sync(); else { const kptr_t kp_ = kargs_opaque(); XcdBarrier b_; b_.bar = (unsigned*)(karg<unsigned char>(kp_, A_WS) + WS_CTL) + CW_BAR; b_.x = xb_xcc_id(); \
        b_.st = (volatile LAS unsigned*)((LAS unsigned char*)lds + MISC_OFF) + 8; xcd_barrier(b_); } } } while (0)
#endif

    if (IN(0)) { phase_prologue(lds); SEAM(0); }
    if (IN(1)) { phase_rowpass<false, true, true, false>(lds, 0, 0); SEAM(1); }
#pragma unroll 1
    for (int l = 0; l < DEPTH; ++l) {
        const int pb = 2 + 5 * l;
        if (IN(pb)) {
            const kptr_t kp = kargs_opaque();
            pg8::Gemm g{WSP(const bf16, WS_H), WSP(const bf16, WS_WIN) + (size_t)l * DIN * D, M, DIN, D}; pg8::StaticOrder So; So.init(M, DIN, opaque_G(), opaque_bx());
            #if ATTN_V128
            const float qscale = 0.125f * 1.4426950408889634f;
#else
            const float qscale = attn_body::C2;
#endif
            pg8::EpiInProj E{WSP(bf16, WS_Z), ZSTRIDE, WSP(const float, WS_ROPE), WSP(const float, WS_ROPE) + (size_t)M * 32, qscale};
#ifndef NO_G1
            pg8::gemm_phase<pg8::EpiInProj, pg8::StaticOrder, true, true>((LAS unsigned char*)lds, g, So, E);
#endif
            SEAM(pb);
        }
        if (IN(pb + 1)) {
            const kptr_t kp = kargs_opaque();
            bf16* Zp = WSP(bf16, WS_Z); bf16* Op = WSP(bf16, WS_O);
#if ATTN_V128
            const attn2::Tensors AT{(const attn2::bf16*)(Zp + 2 * ZSTRIDE), (const attn2::bf16*)(Zp + 3 * ZSTRIDE), (const attn2::bf16*)(Zp + 4 * ZSTRIDE), (attn2::bf16*)Op, (attn2::bf16*)(Op + ZSTRIDE)};
            attn2::phase((char*)lds, AT, opaque_G(), opaque_bx());
#else
            const attn_body::AttnTensors AT{(const attn_body::bf16*)(Zp + 2 * ZSTRIDE), (const attn_body::bf16*)(Zp + 3 * ZSTRIDE), (const attn_body::bf16*)(Zp + 4 * ZSTRIDE),
                                            (attn_body::bf16*)Op, (attn_body::bf16*)(Op + ZSTRIDE)};
            const attn_body::StaticOrder Sa(opaque_G(), opaque_bx());
#ifndef NO_ATTN
            attn_body::attn_phase<attn_body::StaticOrder>((char*)lds, AT, Sa);
#endif
#endif
            phase_pooled(lds);
            SEAM(pb + 1);
        }
        if (IN(pb + 2)) {
            const kptr_t kp = kargs_opaque();
            int kpool = 256; asm volatile("" : "+s"(kpool));
            pg8::Gemm g{WSP(const bf16, WS_POOLED), WSP(const bf16, WS_WPOOL) + (size_t)l * 4 * 65536, 4 * M, 256, kpool}; pg8::PoolOrder Sp{opaque_G(), opaque_bx()};
            pg8::EpiPool E{WSP(bf16, WS_MIX), WSP(const bf16, WS_Z) + ZSTRIDE, karg<const float>(kp, A_PSCALE) + (size_t)l * 1024};
#ifndef NO_G2
            pg8::gemm_phase<pg8::EpiPool, pg8::PoolOrder, true, true>((LAS unsigned char*)lds, g, Sp, E);
#endif
            phase_diffcombine(lds, l);
            SEAM(pb + 2);
        }
        if (IN(pb + 3)) {
            const kptr_t kp = kargs_opaque();
            pg8::Gemm g{WSP(const bf16, WS_MIX), WSP(const bf16, WS_WOUT) + (size_t)l * D * D, M, D, D}; pg8::StaticOrder So; So.init(M, D, opaque_G(), opaque_bx());
            pg8::EpiPlain E{WSP(bf16, WS_Y), D};
#ifndef NO_G3
            pg8::gemm_phase<pg8::EpiPlain, pg8::StaticOrder, true, true>((LAS unsigned char*)lds, g, So, E);
#endif
            SEAM(pb + 3);
        }
        if (IN(pb + 4)) {
            if (l == 0) phase_rowpass<true, true, true, false>(lds, l, l + 1);
            else if (l + 1 < DEPTH) phase_rowpass<true, true, false, false>(lds, l, l + 1);
            else phase_rowpass<true, false, false, true>(lds, l, l);
            SEAM(pb + 4);
        }
    }
#undef IN
#undef SEAM
}

extern "C" void kernel_launch(void* const* d_in, const int* in_sizes, int n_in, void* d_out, int out_size, void* d_ws, size_t ws_size, hipStream_t stream) {
    static int grid = 0;
    if (grid == 0) {
        if (n_in != 16 || in_sizes[0] != M * D || out_size != M * D || ws_size < WS_END) { fprintf(stderr, "kernel_launch: unexpected shapes (n_in %d, in0 %d, out %d, ws %zu)\n", n_in, n_in > 0 ? in_sizes[0] : -1, out_size, ws_size); grid = -1; return; }
        int dev = 0, cus = 0, per_cu = 0;
        if (hipGetDevice(&dev) != hipSuccess || hipDeviceGetAttribute(&cus, hipDeviceAttributeMultiprocessorCount, dev) != hipSuccess) { fprintf(stderr, "kernel_launch: device query failed\n"); grid = -1; return; }
        if (hipFuncSetAttribute((const void*)mega_fwd, hipFuncAttributeMaxDynamicSharedMemorySize, LDS_BYTES) != hipSuccess) { fprintf(stderr, "kernel_launch: hipFuncSetAttribute failed\n"); grid = -1; return; }
        if (hipOccupancyMaxActiveBlocksPerMultiprocessor(&per_cu, (const void*)mega_fwd, NWAVES * 64, LDS_BYTES) != hipSuccess || per_cu < 1) { fprintf(stderr, "kernel_launch: occupancy query says %d blocks per CU\n", per_cu); per_cu = 1; }
        (void)hipGetLastError();
        grid = cus;
    }
    if (grid < 0) return;
    if (hipMemsetAsync((char*)d_ws + WS_CTL, 0, CTL_ZERO_BYTES, stream) != hipSuccess) { fprintf(stderr, "kernel_launch: hipMemsetAsync failed\n"); return; }
    Args a{};
    for (int i = 0; i < 16; ++i) a.in[i] = d_in[i];
    a.out = (float*)d_out; a.ws = (unsigned char*)d_ws;
#if MK_MULTI
    for (int p = 0; p < N_PHASES; ++p) { a.ph_lo = p; a.ph_hi = p + 1; hipLaunchKernelGGL(mega_fwd, dim3(grid), dim3(NWAVES * 64), LDS_BYTES, stream, a); }
#else
    a.ph_lo = 0; a.ph_hi = N_PHASES;
    void* kargs[] = {&a};
    hipError_t e = hipLaunchCooperativeKernel((const void*)mega_fwd, dim3(grid), dim3(NWAVES * 64), kargs, LDS_BYTES, stream);
    if (e != hipSuccess) fprintf(stderr, "kernel_launch: cooperative launch failed: %s (grid %d)\n", hipGetErrorString(e), grid);
#endif
}
```

```cpp
#include <hip/hip_runtime.h>
#include <hip/hip_cooperative_groups.h>
#include <hip/hip_bf16.h>
#include <cstdio>
#include <cstdint>
#include <cstddef>
#include <cmath>
namespace pg8 {
#define PG8_LAS __attribute__((address_space(3)))
typedef unsigned short bf16_t;
typedef short bf16x8 __attribute__((ext_vector_type(8)));
typedef float f32x4 __attribute__((ext_vector_type(4)));
typedef unsigned u32x4 __attribute__((ext_vector_type(4)));
constexpr int BM = 256, BK = 64, HALF = 128, HTB = HALF * BK * 2  , STAGE_BYTES = 8 * HTB, NXCD = 8, WGM = 8;

__host__ __device__ __forceinline__ int lds_byte(int r, int c) { const int st = (r >> 4) * 2 + (c >> 5), rr = r & 15, cc = c & 31, ob = rr * 64 + cc * 2; return st * 1024 + (ob ^ (((ob >> 9) & 1) << 5)); }
__host__ __device__ __forceinline__ void stage_rc(int b, int& R, int& C) { const int st = b / 1024, sb = b % 1024, swz = sb ^ (((sb >> 9) & 1) << 5); R = (st >> 1) * 16 + swz / 64; C = (st & 1) * 32 + (swz % 64) / 2; }
__host__ __device__ __forceinline__ int perm32(int rho) { const int n = rho >> 4, i = rho & 15; return 8 * (i >> 2) + 4 * n + (i & 3); }

struct Unit { int pm, pn; };
struct Gemm { const bf16_t* A; const bf16_t* Bt; int M, N, K; };

struct StaticOrder {
    int nM, nN, nwg, G, c;
    __host__ __device__ void init(int M, int N, int G_, int c_) { nM = M / BM; nN = N / BM; nwg = nM * nN; G = G_; c = c_; }
    __host__ __device__ bool next(int i, Unit& u) const {
        const long L = (long)i * G + c; if (L >= nwg) return false;
        int wgid = (int)L; { const int q = nwg / NXCD, r = nwg % NXCD, xcd = wgid % NXCD, off = wgid / NXCD; wgid = (xcd < r ? xcd * (q + 1) : r * (q + 1) + (xcd - r) * q) + off; }
        const int nig = WGM * nN, gid = wgid / nig, fm = gid * WGM, gsz = (nM - fm) < WGM ? (nM - fm) : WGM;
        u.pm = fm + ((wgid % nig) % gsz); u.pn = (wgid % nig) / gsz; return true;
    }
    __device__ __forceinline__ void a_ready(const Unit&) const {}
    __device__ __forceinline__ void done(const Unit&) const {}
};

__device__ __forceinline__ unsigned cvt_pk_bf16(float lo, float hi) { unsigned r; asm volatile("v_cvt_pk_bf16_f32 %0, %1, %2" : "=v"(r) : "v"(lo), "v"(hi)); return r; }
typedef unsigned u32x2 __attribute__((ext_vector_type(2)));
__device__ __forceinline__ float bf_lo(unsigned w) { return __uint_as_float(w << 16); }
__device__ __forceinline__ float bf_hi(unsigned w) { return __uint_as_float(w & 0xffff0000u); }
__device__ __forceinline__ float silu_f(float g) { return g * __builtin_amdgcn_rcpf(1.0f + __builtin_amdgcn_exp2f(-1.4426950408889634f * g)); }

struct EpiPlain {
    static constexpr bool PERM = true, AFTER_DRAIN = false;
    bf16_t* O; int ldc;
    __device__ __forceinline__ void operator()(const f32x4 (&acc)[2][2][4][2], const Unit& u, int wr, int wc, int fr, int fq) const {
        const int row0 = u.pm * BM + wr * 64 + fr; const int col0 = u.pn * BM + wc * 32 + 8 * fq;
#pragma unroll
        for (int ai = 0; ai < 2; ++ai)
#pragma unroll
            for (int m = 0; m < 4; ++m) { bf16_t* rowp = O + (size_t)(row0 + ai * HALF + m * 16) * ldc + col0;
#pragma unroll
                for (int bj = 0; bj < 2; ++bj) { const f32x4 v0 = acc[ai][bj][m][0], v1 = acc[ai][bj][m][1];
                    u32x4 w; w.x = cvt_pk_bf16(v0[0], v0[1]); w.y = cvt_pk_bf16(v0[2], v0[3]); w.z = cvt_pk_bf16(v1[0], v1[1]); w.w = cvt_pk_bf16(v1[2], v1[3]);
                    *(u32x4*)(rowp + bj * HALF) = w; } }
    }
};

struct EpiInProj {
    static constexpr bool PERM = true, AFTER_DRAIN = false;
    bf16_t* Z; size_t zstride; const float* cosT; const float* sinT; float qscale;
    __device__ __forceinline__ void operator()(const f32x4 (&acc)[2][2][4][2], const Unit& u, int wr, int wc, int fr, int fq) const {
        const int row0 = u.pm * BM + wr * 64 + fr; const int t = u.pn >> 2; const int colt = (u.pn & 3) * BM;
        bf16_t* base = Z + (size_t)t * zstride;
        if (t == 2 || t == 3) {
            const float sc = (t == 2) ? qscale : 1.0f; const int g = 4 * (wc & 1) + fq;
#pragma unroll
            for (int ai = 0; ai < 2; ++ai)
#pragma unroll
                for (int m = 0; m < 4; ++m) { const int r = row0 + ai * HALF + m * 16;
                    f32x4 cs = *(const f32x4*)(cosT + (size_t)r * 32 + 4 * g), sn = *(const f32x4*)(sinT + (size_t)r * 32 + 4 * g); cs = cs * sc; sn = sn * sc;
#pragma unroll
                    for (int bj = 0; bj < 2; ++bj) { const f32x4 v0 = acc[ai][bj][m][0], v1 = acc[ai][bj][m][1];
                        const f32x4 o0 = v0 * cs - v1 * sn, o1 = v1 * cs + v0 * sn;
                        bf16_t* p = base + (size_t)r * 1024 + colt + bj * HALF + (wc >> 1) * 64 + 4 * g;
                        u32x2 w0, w1; w0.x = cvt_pk_bf16(o0[0], o0[1]); w0.y = cvt_pk_bf16(o0[2], o0[3]); w1.x = cvt_pk_bf16(o1[0], o1[1]); w1.y = cvt_pk_bf16(o1[2], o1[3]);
                        *(u32x2*)p = w0; *(u32x2*)(p + 32) = w1; } }
        } else {
            const int col0 = colt + wc * 32 + 8 * fq;
#pragma unroll
            for (int ai = 0; ai < 2; ++ai)
#pragma unroll
                for (int m = 0; m < 4; ++m) { bf16_t* rowp = base + (size_t)(row0 + ai * HALF + m * 16) * 1024 + col0;
#pragma unroll
                    for (int bj = 0; bj < 2; ++bj) { const f32x4 v0 = acc[ai][bj][m][0], v1 = acc[ai][bj][m][1];
                        u32x4 w; w.x = cvt_pk_bf16(v0[0], v0[1]); w.y = cvt_pk_bf16(v0[2], v0[3]); w.z = cvt_pk_bf16(v1[0], v1[1]); w.w = cvt_pk_bf16(v1[2], v1[3]);
                        *(u32x4*)(rowp + bj * HALF) = w; } }
        }
    }
};

struct EpiPool {
    static constexpr bool PERM = true, AFTER_DRAIN = false;
    bf16_t* MIX; const bf16_t* GP; const float* ps;
    __device__ __forceinline__ void operator()(const f32x4 (&acc)[2][2][4][2], const Unit& u, int wr, int wc, int fr, int fq) const {
        const int grp = u.pm >> 6; const int tok0 = (u.pm & 63) * BM + wr * 64 + fr; const int col0 = grp * 256 + wc * 32 + 8 * fq;
        f32x4 sv[2][2];
#pragma unroll
        for (int bj = 0; bj < 2; ++bj)
#pragma unroll
            for (int n = 0; n < 2; ++n) sv[bj][n] = *(const f32x4*)(ps + col0 + bj * HALF + 4 * n);
#pragma unroll
        for (int ai = 0; ai < 2; ++ai)
#pragma unroll
            for (int m = 0; m < 4; ++m) { const size_t tok = (size_t)(tok0 + ai * HALF + m * 16);
#pragma unroll
                for (int bj = 0; bj < 2; ++bj) { const int col = col0 + bj * HALF;
                    const u32x4 gv = *(const u32x4*)(GP + tok * 1024 + col);
                    const f32x4 v0 = acc[ai][bj][m][0] * sv[bj][0], v1 = acc[ai][bj][m][1] * sv[bj][1];
                    u32x4 w;
                    w.x = cvt_pk_bf16(v0[0] * silu_f(bf_lo(gv.x)), v0[1] * silu_f(bf_hi(gv.x))); w.y = cvt_pk_bf16(v0[2] * silu_f(bf_lo(gv.y)), v0[3] * silu_f(bf_hi(gv.y)));
                    w.z = cvt_pk_bf16(v1[0] * silu_f(bf_lo(gv.z)), v1[1] * silu_f(bf_hi(gv.z))); w.w = cvt_pk_bf16(v1[2] * silu_f(bf_lo(gv.w)), v1[3] * silu_f(bf_hi(gv.w)));
                    *(u32x4*)(MIX + tok * 2048 + col) = w; }
                asm volatile("" ::: "memory"); }
    }
};
struct PoolOrder {
    int G, c;
    __device__ __forceinline__ bool next(int i, Unit& u) const { const int L = i * G + c; if (L >= 256) return false; u.pm = L; u.pn = L >> 6; return true; }
    __device__ __forceinline__ void a_ready(const Unit&) const {}
    __device__ __forceinline__ void done(const Unit&) const {}
};

template <class Epi, class Sched, bool ALIGN_EPI = false, bool SP2 = false>
__device__ __forceinline__ void gemm_phase(PG8_LAS unsigned char* lds, const Gemm g, const Sched& S, const Epi& E) {
    int tid_ = threadIdx.x; asm volatile("" : "+v"(tid_));
    const int tid = tid_, wid = __builtin_amdgcn_readfirstlane(tid >> 6), lane = tid & 63, wr = wid >> 2, wc = wid & 3, fr = lane & 15, fq = lane >> 4;
    const int K = g.K, nt = K / BK;
    unsigned voffA[2], voffB[2];
#pragma unroll
    for (int i = 0; i < 2; ++i) { int R, C; stage_rc(tid * 16 + i * 8192, R, C); const int Rb = Epi::PERM ? ((R & ~31) + perm32(R & 31)) : R;
        voffA[i] = (unsigned)(R * K + C) * 2u; voffB[i] = (unsigned)(Rb * K + C) * 2u; }
    const size_t kstep = (size_t)(BK * 2);
    const size_t hstep = (size_t)HALF * K * 2;
    const size_t tstep = 2 * hstep;
    const unsigned ldsw = (unsigned)wid * 1024u;
    const int aoff = lds_byte(wr * 64 + fr, fq * 8), boff = lds_byte(wc * 32 + fr, fq * 8);
#define PG8_SA(b, h) (((b) * 2 + (h)) * HTB)
#define PG8_SB(b, h) ((4 + (b) * 2 + (h)) * HTB)
#define PG8_STAGE(bufoff, gbase, voff) do { _Pragma("unroll") for (int _i = 0; _i < 2; ++_i) \
        __builtin_amdgcn_global_load_lds((const unsigned*)((const char*)(gbase) + (voff)[_i]), (PG8_LAS unsigned*)(lds + (bufoff) + ldsw + _i * 8192), 16, 0, 0); } while (0)
#define PG8_LDA(dst, b, h) do { _Pragma("unroll") for (int m = 0; m < 4; ++m) _Pragma("unroll") for (int k = 0; k < 2; ++k) dst[m][k] = *(const PG8_LAS bf16x8*)(lds + PG8_SA(b, h) + aoff + m * 2048 + k * 1024); } while (0)
#define PG8_LDB(dst, b, h) do { _Pragma("unroll") for (int n = 0; n < 2; ++n) _Pragma("unroll") for (int k = 0; k < 2; ++k) dst[n][k] = *(const PG8_LAS bf16x8*)(lds + PG8_SB(b, h) + boff + n * 2048 + k * 1024); } while (0)
#define PG8_MMA(ai, bj, At, Bt) do { __builtin_amdgcn_s_setprio(1); _Pragma("unroll") for (int m = 0; m < 4; ++m) _Pragma("unroll") for (int n = 0; n < 2; ++n) _Pragma("unroll") for (int k = 0; k < 2; ++k) \
        acc[ai][bj][m][n] = __builtin_amdgcn_mfma_f32_16x16x32_bf16(Bt[n][k], At[m][k], acc[ai][bj][m][n], 0, 0, 0); __builtin_amdgcn_s_setprio(0); } while (0)
#define PG8_WAIT_V(n) asm volatile("s_waitcnt vmcnt(" #n ")" ::: "memory")
#define PG8_WAIT_L(n) asm volatile("s_waitcnt lgkmcnt(" #n ")" ::: "memory")
#define PG8_BAR __builtin_amdgcn_s_barrier()
#define PG8_SCHED __builtin_amdgcn_sched_barrier(0)
    Unit cur, nxt; int ui = 0;
    if (!S.next(0, cur)) return;
    f32x4 acc[2][2][4][2];
#pragma unroll
    for (int a = 0; a < 2; ++a)
#pragma unroll
        for (int b = 0; b < 2; ++b)
#pragma unroll
            for (int m = 0; m < 4; ++m)
#pragma unroll
                for (int n = 0; n < 2; ++n) acc[a][b][m][n] = (f32x4){0.f, 0.f, 0.f, 0.f};
    bf16x8 At[4][2], B0[2][2], B1[2][2];
    const char* cA = (const char*)g.A + (size_t)cur.pm * tstep; const char* cB = (const char*)g.Bt + (size_t)cur.pn * tstep;
    S.a_ready(cur);
    if constexpr (SP2) {
        PG8_STAGE(PG8_SB(0, 0), cB, voffB); PG8_STAGE(PG8_SB(0, 1), cB + hstep, voffB); PG8_STAGE(PG8_SA(0, 0), cA, voffA); PG8_STAGE(PG8_SA(0, 1), cA + hstep, voffA);
        if (wr == 1) PG8_BAR;
        PG8_WAIT_V(2); PG8_BAR;
        PG8_STAGE(PG8_SB(1, 0), cB + kstep, voffB); PG8_STAGE(PG8_SA(1, 0), cA + kstep, voffA); PG8_STAGE(PG8_SB(1, 1), cB + hstep + kstep, voffB);
        PG8_WAIT_V(6); PG8_BAR;
    } else {
        PG8_STAGE(PG8_SB(0, 0), cB, voffB); PG8_STAGE(PG8_SA(0, 0), cA, voffA); PG8_STAGE(PG8_SB(0, 1), cB + hstep, voffB); PG8_STAGE(PG8_SA(0, 1), cA + hstep, voffA);
        if (wr == 1) PG8_BAR;
        PG8_WAIT_V(4); PG8_BAR;
        PG8_STAGE(PG8_SB(1, 0), cB + kstep, voffB); PG8_STAGE(PG8_SA(1, 0), cA + kstep, voffA); PG8_STAGE(PG8_SB(1, 1), cB + hstep + kstep, voffB);
        PG8_WAIT_V(6); PG8_BAR;
    }
    for (;;) {
        const bool has_next = S.next(ui + 1, nxt);
        const char* nA = has_next ? (const char*)g.A + (size_t)nxt.pm * tstep : cA; const char* nB = has_next ? (const char*)g.Bt + (size_t)nxt.pn * tstep : cB;
        for (int t = 0; t < nt; t += 2) {
            const bool last = (t == nt - 2);
            const char* a1 = cA + (size_t)(t + 1) * kstep;
            const char* a2 = last ? nA : cA + (size_t)(t + 2) * kstep; const char* b2 = last ? nB : cB + (size_t)(t + 2) * kstep;
            const char* a3 = a2 + kstep; const char* b3 = b2 + kstep;
            if (last && has_next) S.a_ready(nxt);
            if constexpr (SP2) {
            PG8_LDB(B0, 0, 0); PG8_LDB(B1, 0, 1); PG8_SCHED; PG8_LDA(At, 0, 0); PG8_STAGE(PG8_SA(1, 1), a1 + hstep, voffA);
            PG8_WAIT_V(8); PG8_WAIT_L(0); PG8_BAR; PG8_MMA(0, 0, At, B0); PG8_MMA(0, 1, At, B1); PG8_BAR; PG8_SCHED;
            PG8_LDA(At, 0, 1); PG8_STAGE(PG8_SB(0, 0), b2, voffB); PG8_STAGE(PG8_SB(0, 1), b2 + hstep, voffB); PG8_STAGE(PG8_SA(0, 0), a2, voffA);
            PG8_WAIT_V(8); PG8_WAIT_L(0); PG8_BAR; PG8_MMA(1, 0, At, B0); PG8_MMA(1, 1, At, B1); PG8_BAR; PG8_SCHED;
            PG8_LDB(B0, 1, 0); PG8_LDB(B1, 1, 1); PG8_SCHED; PG8_LDA(At, 1, 0); PG8_STAGE(PG8_SA(0, 1), a2 + hstep, voffA);
            PG8_WAIT_V(8); PG8_WAIT_L(0); PG8_BAR; PG8_MMA(0, 0, At, B0); PG8_MMA(0, 1, At, B1); PG8_BAR; PG8_SCHED;
            PG8_LDA(At, 1, 1); PG8_STAGE(PG8_SB(1, 0), b3, voffB); PG8_STAGE(PG8_SB(1, 1), b3 + hstep, voffB); PG8_STAGE(PG8_SA(1, 0), a3, voffA);
            PG8_WAIT_V(8); PG8_WAIT_L(0); PG8_BAR; PG8_MMA(1, 0, At, B0); PG8_MMA(1, 1, At, B1); PG8_BAR; PG8_SCHED;
            } else {
            PG8_LDB(B0, 0, 0); PG8_SCHED; PG8_LDA(At, 0, 0); PG8_STAGE(PG8_SA(1, 1), a1 + hstep, voffA);
            PG8_WAIT_L(8); PG8_BAR; PG8_WAIT_L(0); PG8_MMA(0, 0, At, B0); PG8_BAR; PG8_SCHED;
            PG8_LDB(B1, 0, 1); PG8_STAGE(PG8_SB(0, 0), b2, voffB);
            PG8_BAR; PG8_WAIT_L(0); PG8_MMA(0, 1, At, B1); PG8_BAR;
            PG8_LDA(At, 0, 1); PG8_STAGE(PG8_SA(0, 0), a2, voffA);
            PG8_BAR; PG8_WAIT_L(0); PG8_MMA(1, 0, At, B0); PG8_BAR; PG8_SCHED;
            PG8_STAGE(PG8_SB(0, 1), b2 + hstep, voffB);
            PG8_WAIT_V(6); PG8_BAR; PG8_MMA(1, 1, At, B1); PG8_BAR;
            PG8_LDB(B0, 1, 0); PG8_SCHED; PG8_LDA(At, 1, 0); PG8_STAGE(PG8_SA(0, 1), a2 + hstep, voffA);
            PG8_WAIT_L(8); PG8_BAR; PG8_WAIT_L(0); PG8_MMA(0, 0, At, B0); PG8_BAR; PG8_SCHED;
            PG8_LDB(B1, 1, 1); PG8_STAGE(PG8_SB(1, 0), b3, voffB);
            PG8_BAR; PG8_WAIT_L(0); PG8_MMA(0, 1, At, B1); PG8_BAR;
            PG8_LDA(At, 1, 1); PG8_STAGE(PG8_SA(1, 0), a3, voffA);
            PG8_BAR; PG8_WAIT_L(0); PG8_MMA(1, 0, At, B0); PG8_BAR; PG8_SCHED;
            PG8_STAGE(PG8_SB(1, 1), b3 + hstep, voffB);
            PG8_WAIT_V(6); PG8_BAR; PG8_MMA(1, 1, At, B1); PG8_BAR;
            }
        }
        if constexpr (ALIGN_EPI) { if (wr == 0) PG8_BAR; }
        if constexpr (!Epi::AFTER_DRAIN) { E(acc, cur, wr, wc, fr, fq); S.done(cur); }
        if (!has_next) break;
#pragma unroll
        for (int a = 0; a < 2; ++a)
#pragma unroll
            for (int b = 0; b < 2; ++b)
#pragma unroll
                for (int m = 0; m < 4; ++m)
#pragma unroll
                    for (int n = 0; n < 2; ++n) acc[a][b][m][n] = (f32x4){0.f, 0.f, 0.f, 0.f};
        cur = nxt; cA = nA; cB = nB; ++ui;
        if constexpr (ALIGN_EPI) { if (wr == 1) PG8_BAR; }
    }
    PG8_WAIT_V(0);
    if constexpr (!ALIGN_EPI) { if (wr == 0) PG8_BAR; }
    PG8_BAR;
    if constexpr (Epi::AFTER_DRAIN) { E.fused(acc, cur, wr, wc, fr, fq, lds, wid, lane); S.done(cur); }
#undef PG8_SA
#undef PG8_SB
#undef PG8_STAGE
#undef PG8_LDA
#undef PG8_LDB
#undef PG8_MMA
#undef PG8_WAIT_V
#undef PG8_WAIT_L
#undef PG8_BAR
#undef PG8_SCHED
}
}
namespace attn_body {
using bf16=__hip_bfloat16;
using bf16x8=__attribute__((ext_vector_type(8)))short;
using s16x4=__attribute__((ext_vector_type(4)))short;
using f32x16=__attribute__((ext_vector_type(16)))float;
using u32x4=__attribute__((ext_vector_type(4)))unsigned;
constexpr int BATCH=4,NHEAD=16,SEQ=4096,D=64,DM=NHEAD*D;
constexpr int NW=8,QBLK=32,QB=QBLK*NW,KVBLK=64,NQB=SEQ/QB;
constexpr int ATTN_PITCH=DM, ATTN_UNIT_ROWS=QB;
__device__ __forceinline__ int crow(int r,int hi){return (r&3)+8*(r>>2)+4*hi;}
#define SBAR() __builtin_amdgcn_sched_barrier(0)
__device__ __forceinline__ void cmask(f32x16&p0,f32x16&p1,int jb,int qrel,int hi){
  const float NEG=-INFINITY; int kb=64*jb+4*hi;
  #pragma unroll
  for(int r=0;r<16;++r){int kv=kb+(r&3)+8*(r>>2); if(kv>(qrel|63))p0[r]=NEG; if(kv+32>(qrel|63))p1[r]=NEG;}
}

constexpr int NSLOT=3, SLOTB=8192;
constexpr int LDS_K=0, LDS_V=NSLOT*SLOTB, LDS_WS=2*NSLOT*SLOTB, LDS_OST=LDS_WS+NW*64*4, LDS_BYTES=LDS_OST+NW*4096;
constexpr float C2=0.125f*1.4426950408889634f;
__device__ __forceinline__ void glds16(const void*gsrc,unsigned lds_dst){unsigned keep;
  asm volatile("s_mov_b32 %0, m0\n\ts_mov_b32 m0, %2\n\ts_nop 0\n\tglobal_load_lds_dwordx4 %1, off\n\ts_mov_b32 m0, %0":"=&s"(keep):"v"(gsrc),"s"(lds_dst):"memory");}
__device__ __forceinline__ float max3f(float a,float b,float c){float r;asm("v_max3_f32 %0, %1, %2, %3":"=v"(r):"v"(a),"v"(b),"v"(c));return r;}
__device__ __forceinline__ float max2f(float a,float b){float r;asm("v_max_f32_e32 %0, %1, %2":"=v"(r):"v"(a),"v"(b));return r;}
__device__ __forceinline__ float fadd_s(float a,float b){float r;asm("v_add_f32_e32 %0, %1, %2":"=v"(r):"v"(a),"v"(b));return r;}
__device__ __forceinline__ float fsub_s(float a,float b){float r;asm("v_sub_f32_e32 %0, %1, %2":"=v"(r):"v"(a),"v"(b));return r;}
typedef float f32x2_t __attribute__((ext_vector_type(2))); typedef __bf16 bf16x2_t __attribute__((ext_vector_type(2)));
__device__ __forceinline__ unsigned cvtpk_s(float lo,float hi){f32x2_t v={lo,hi};bf16x2_t b=__builtin_convertvector(v,bf16x2_t);return __builtin_bit_cast(unsigned,b);}
#define WAIT_BAR(N) asm volatile("s_waitcnt vmcnt(" #N ") lgkmcnt(0)\n\ts_barrier":::"memory")

__device__ __forceinline__ void qkt(f32x16&p0,f32x16&p1,const char*Kslot,const bf16x8*qr,const f32x16&negm,int r32,int hi){
  const char*kb=Kslot+hi*1024+r32*16;
  #pragma unroll
  for(int d0=0;d0<4;++d0){
    const bf16x8 b0=*reinterpret_cast<const bf16x8*>(kb+d0*2048);
    const bf16x8 b1=*reinterpret_cast<const bf16x8*>(kb+d0*2048+512);
    if(d0==0){p0=__builtin_amdgcn_mfma_f32_32x32x16_bf16(b0,qr[0],negm,0,0,0);p1=__builtin_amdgcn_mfma_f32_32x32x16_bf16(b1,qr[0],negm,0,0,0);}
    else{p0=__builtin_amdgcn_mfma_f32_32x32x16_bf16(b0,qr[d0],p0,0,0,0);p1=__builtin_amdgcn_mfma_f32_32x32x16_bf16(b1,qr[d0],p1,0,0,0);}}
}
typedef __attribute__((address_space(3))) const char* lds_cptr;
typedef short v4i16_t __attribute__((ext_vector_type(4)));
__device__ __forceinline__ void kload8(bf16x8*kf,lds_cptr kp){
  kf[0]=*(const __attribute__((address_space(3))) bf16x8*)(kp);      kf[1]=*(const __attribute__((address_space(3))) bf16x8*)(kp+512);
  kf[2]=*(const __attribute__((address_space(3))) bf16x8*)(kp+2048); kf[3]=*(const __attribute__((address_space(3))) bf16x8*)(kp+2560);
  kf[4]=*(const __attribute__((address_space(3))) bf16x8*)(kp+4096); kf[5]=*(const __attribute__((address_space(3))) bf16x8*)(kp+4608);
  kf[6]=*(const __attribute__((address_space(3))) bf16x8*)(kp+6144); kf[7]=*(const __attribute__((address_space(3))) bf16x8*)(kp+6656);
}
__device__ __forceinline__ void kload2(bf16x8*kf,lds_cptr kp,int j){ kf[2*j]=*(const __attribute__((address_space(3))) bf16x8*)(kp+j*2048); kf[2*j+1]=*(const __attribute__((address_space(3))) bf16x8*)(kp+j*2048+512); }
__device__ __forceinline__ s16x4 vtr(lds_cptr p){ return __builtin_bit_cast(s16x4,__builtin_amdgcn_ds_read_tr16_b64_v4i16((__attribute__((address_space(3))) v4i16_t*)p)); }
__device__ __forceinline__ float rowmax(const f32x16&p0,const f32x16&p1){
  float a=max3f(p0[0],p0[1],p1[0]),b=max3f(p0[2],p0[3],p1[1]);a=max3f(a,p1[2],p1[3]);
  #pragma unroll
  for(int r=4;r<16;r+=4){a=max3f(a,p0[r],p0[r+1]);b=max3f(b,p0[r+2],p0[r+3]);a=max3f(a,p1[r],p1[r+1]);b=max3f(b,p1[r+2],p1[r+3]);}
  const float m=max2f(a,b);
  auto rr=__builtin_amdgcn_permlane32_swap(__float_as_uint(m),__float_as_uint(m),false,false);
  return max2f(__uint_as_float(rr[0]),__uint_as_float(rr[1]));
}
__device__ __forceinline__ void pv(f32x16*o,int vb,bf16x8 pa0,bf16x8 pa1,bf16x8 pa2,bf16x8 pa3){
  #pragma unroll
  for(int d0=0;d0<2;++d0){s16x4 lo[4],hi[4];
    #pragma unroll
    for(int ks=0;ks<4;++ks){
      asm volatile("ds_read_b64_tr_b16 %0,%1 offset:%c2":"=&v"(lo[ks]):"v"(vb),"i"(d0*4096+ks*1024):"memory");
      asm volatile("ds_read_b64_tr_b16 %0,%1 offset:%c2":"=&v"(hi[ks]):"v"(vb),"i"(d0*4096+ks*1024+512):"memory");}
    asm volatile("s_waitcnt lgkmcnt(0)":::"memory");SBAR();
    #define PK(k) (bf16x8){lo[k][0],lo[k][1],lo[k][2],lo[k][3],hi[k][0],hi[k][1],hi[k][2],hi[k][3]}
    o[d0]=__builtin_amdgcn_mfma_f32_32x32x16_bf16(pa0,PK(0),o[d0],0,0,0);
    o[d0]=__builtin_amdgcn_mfma_f32_32x32x16_bf16(pa1,PK(1),o[d0],0,0,0);
    o[d0]=__builtin_amdgcn_mfma_f32_32x32x16_bf16(pa2,PK(2),o[d0],0,0,0);
    o[d0]=__builtin_amdgcn_mfma_f32_32x32x16_bf16(pa3,PK(3),o[d0],0,0,0);
    #undef PK
  }
}

#ifndef ATTN_STORE16
#define ATTN_STORE16(p,v) (*(u32x4*)(p)=(v))
#endif
template<int THRL> __device__ __forceinline__ void attn_unit(int b,int hq,int hv,int qb,const bf16*__restrict__ Q,const bf16*__restrict__ K,const bf16*__restrict__ V,bf16*__restrict__ O,char*shm){
  int tid_=threadIdx.x; asm volatile("":"+v"(tid_)); const int tid=tid_,lane=tid&63,r32=lane&31,hi=lane>>5; const int wid=__builtin_amdgcn_readfirstlane(tid>>6);
  const long rowbase=(long)b*SEQ; const int q0=qb*QB;
  const bf16*Qw=Q+(rowbase+q0+wid*QBLK)*DM+hq*D;
  const bf16*Kh=K+rowbase*DM+hq*D,*Vh=V+rowbase*DM+hv*D;
  const unsigned lds0=(unsigned)(uintptr_t)shm;
  float*wsf=(float*)(shm+LDS_WS)+wid*64;
  const bf16*ksrc=Kh+(long)lane*DM+wid*8;
  const bf16*vsrc=Vh+(long)(16*(wid&3)+(lane>>2))*DM+(wid>>2)*32+(lane&3)*8;
  const unsigned kdst=lds0+LDS_K+wid*1024, vdst=lds0+LDS_V+wid*1024;
  #define DMA_K(t,slot) glds16(ksrc+(long)(t)*KVBLK*DM,(unsigned)__builtin_amdgcn_readfirstlane(kdst+(slot)))
  #define DMA_V(t,slot) glds16(vsrc+(long)(t)*KVBLK*DM,(unsigned)__builtin_amdgcn_readfirstlane(vdst+(slot)))
  const int vb0=(int)(lds0+LDS_V)+((lane>>4)&1)*32+(lane&3)*8+(4*hi+((lane&15)>>2))*64;
  const char*Kbase=shm+LDS_K; bf16x8 kf[8];
  const lds_cptr shm3=(lds_cptr)shm; const lds_cptr kp0=shm3+LDS_K+hi*1024+r32*16; const lds_cptr vp0=shm3+LDS_V+((lane>>4)&1)*32+(lane&3)*8+(4*hi+((lane&15)>>2))*64;
  const int NT=(q0+QB)/KVBLK;
  DMA_K(0,0);DMA_V(0,0);DMA_K(1,SLOTB);
  bf16x8 qr[4];
  #pragma unroll
  for(int d0=0;d0<4;++d0)qr[d0]=*reinterpret_cast<const bf16x8*>(&Qw[(long)r32*DM+d0*16+hi*8]);
  float mhat=0.f,l_reg=0.f;f32x16 o[2];o[0]=f32x16{};o[1]=f32x16{};f32x16 negm=f32x16{};asm volatile("":"+v"(negm));
  const int qrel=wid*QBLK+r32;
  #define CMASK(P0,P1,t) do{int jb_=(t)-(NT-4); if(jb_>=0)cmask(P0,P1,jb_,qrel,hi);}while(0)
  bool resc=false;
  #define START(P0,P1) do{ const float rm=rowmax(P0,P1); resc=false; \
    { const float dl=rm; mhat=fadd_s(mhat,dl); \
      _Pragma("unroll") for(int r=0;r<16;++r){P0[r]=fsub_s(P0[r],dl);P1[r]=fsub_s(P1[r],dl);} \
      _Pragma("unroll") for(int r=0;r<16;++r)negm[r]=-mhat; asm volatile("":"+v"(negm)); } \
    _Pragma("unroll") for(int r=0;r<16;++r)P0[r]=__builtin_amdgcn_exp2f(P0[r]); }while(0)
  #define RESC() do{ if(resc){ asm volatile("s_waitcnt lgkmcnt(0)":::"memory"); \
      _Pragma("unroll") for(int d_=0;d_<2;++d_) _Pragma("unroll") for(int r=0;r<16;++r)o[d_][r]*=wsf[crow(r,hi)]; } }while(0)
  f32x16 pA0,pA1,pB0,pB1;
  int sl_prev=0,sl_cur=0,sl_next=SLOTB;
  #define ROT() do{sl_prev=sl_cur;sl_cur=sl_next;sl_next=(sl_next==(NSLOT-1)*SLOTB)?0:sl_next+SLOTB;}while(0)
  DMA_K(2,2*SLOTB);
  WAIT_BAR(3);
  qkt(pA0,pA1,Kbase,qr,negm,r32,hi);asm volatile("s_nop 15\n\ts_nop 7":"+v"(pA0),"+v"(pA1));CMASK(pA0,pA1,0);
  START(pA0,pA1);
  _Pragma("unroll") for(int r=0;r<16;++r)pA1[r]=__builtin_amdgcn_exp2f(pA1[r]);
  WAIT_BAR(0);
  DMA_K(3,0);DMA_V(1,SLOTB);
  ROT();
  kload8(kf,kp0+sl_cur);
  WAIT_BAR(2);
  s16x4 vlo[8],vhi[8]; u32x4 pw0,pw1,pw2,pw3;
  #define PKW(P,B) cvtpk_s(P[B],P[B+1])
  #define PAF(k) __builtin_bit_cast(bf16x8,pw##k)
  #define VFR(i) (bf16x8){vlo[i][0],vlo[i][1],vlo[i][2],vlo[i][3],vhi[i][0],vhi[i][1],vhi[i][2],vhi[i][3]}
  #define PIN(x) asm volatile("":"+v"(x))
  #define MX3(a,b,c) __builtin_fmaxf(__builtin_fmaxf((a),(b)),(c))
  #define GAPA(MF,A0,A1,A2,A3,W0,W1,PW) do{ MF; sacc+=A0; sacc+=A1; sacc+=A2; sacc+=A3; PIN(sacc); W0; W1; PIN(PW); SBAR(); }while(0)
  #define EX(v) __builtin_amdgcn_exp2f(v)
  #define GAPB(MF,X,B) do{ MF; X[B]=EX(X[B]); X[B+1]=EX(X[B+1]); X[B+2]=EX(X[B+2]); X[B+3]=EX(X[B+3]); PIN(X); SBAR(); }while(0)
  #define VRD(i) do{ vlo[i]=vtr(vp_+(((i)>>2)*4096+((i)&3)*1024)); vhi[i]=vtr(vp_+(((i)>>2)*4096+((i)&3)*1024+512)); }while(0)
  #define KRD(G,j) do{ if(G){ kload2(kf,kp0+sl_next,j); SBAR(); } }while(0)
  #define STEP(C0,C1,P0,P1,t,GK,GV,GL) do{ SBAR(); \
    const lds_cptr vp_=vp0+sl_prev; \
    VRD(0); SBAR(); float sacc=(P0[0]+P0[1]); \
    GAPA(C0=__builtin_amdgcn_mfma_f32_32x32x16_bf16(kf[0],qr[0],negm,0,0,0), P0[2],P0[3],P0[4],P0[5],     pw0[0]=PKW(P0,0), pw0[1]=PKW(P0,2), pw0); \
    VRD(4); SBAR(); GAPA(C1=__builtin_amdgcn_mfma_f32_32x32x16_bf16(kf[1],qr[0],negm,0,0,0), P0[6],P0[7],P0[8],P0[9],     pw0[2]=PKW(P0,4), pw0[3]=PKW(P0,6), pw0); \
    VRD(1); SBAR(); GAPA(C0=__builtin_amdgcn_mfma_f32_32x32x16_bf16(kf[2],qr[1],C0,0,0,0),   P0[10],P0[11],P0[12],P0[13], pw1[0]=PKW(P0,8), pw1[1]=PKW(P0,10), pw1); \
    VRD(5); SBAR(); GAPA(C1=__builtin_amdgcn_mfma_f32_32x32x16_bf16(kf[3],qr[1],C1,0,0,0),   P0[14],P0[15],P1[0],P1[1],   pw1[2]=PKW(P0,12),pw1[3]=PKW(P0,14), pw1); \
    VRD(2); SBAR(); GAPA(C0=__builtin_amdgcn_mfma_f32_32x32x16_bf16(kf[4],qr[2],C0,0,0,0),   P1[2],P1[3],P1[4],P1[5],     pw2[0]=PKW(P1,0), pw2[1]=PKW(P1,2), pw2); \
    VRD(6); SBAR(); GAPA(C1=__builtin_amdgcn_mfma_f32_32x32x16_bf16(kf[5],qr[2],C1,0,0,0),   P1[6],P1[7],P1[8],P1[9],     pw2[2]=PKW(P1,4), pw2[3]=PKW(P1,6), pw2); \
    VRD(3); SBAR(); GAPA(C0=__builtin_amdgcn_mfma_f32_32x32x16_bf16(kf[6],qr[3],C0,0,0,0),   P1[10],P1[11],P1[12],P1[13], pw3[0]=PKW(P1,8), pw3[1]=PKW(P1,10), pw3); \
    VRD(7); SBAR(); GAPA(C1=__builtin_amdgcn_mfma_f32_32x32x16_bf16(kf[7],qr[3],C1,0,0,0),   P1[14],P1[15],0.f,0.f,       pw3[2]=PKW(P1,12),pw3[3]=PKW(P1,14), pw3); \
    l_reg+=sacc; \
    if(GK){DMA_K((t)+3,sl_cur);} if(GV){DMA_V((t)+1,sl_next);} \
    CMASK(C0,C1,t); \
    { float a=MX3(C0[0],C0[1],C1[0]),b=MX3(C0[2],C0[3],C1[1]); a=MX3(a,C1[2],C1[3]); \
      _Pragma("unroll") for(int r=4;r<16;r+=4){a=MX3(a,C0[r],C0[r+1]);b=MX3(b,C0[r+2],C0[r+3]);a=MX3(a,C1[r],C1[r+1]);b=MX3(b,C1[r+2],C1[r+3]);} \
      float rm=__builtin_fmaxf(a,b); { auto rr=__builtin_amdgcn_permlane32_swap(__float_as_uint(rm),__float_as_uint(rm),false,false); rm=__builtin_fmaxf(__uint_as_float(rr[0]),__uint_as_float(rr[1])); } \
      resc=false; \
      if(__builtin_expect(__any(rm>(float)THRL),0)){ const float dl=__builtin_fmaxf(rm,0.f); mhat+=dl; \
        _Pragma("unroll") for(int r=0;r<16;++r){C0[r]-=dl;C1[r]-=dl;} \
        _Pragma("unroll") for(int r=0;r<16;++r)negm[r]=-mhat; asm volatile("":"+v"(negm)); \
        const float f=__builtin_amdgcn_exp2f(-dl); l_reg*=f; if(hi==0)wsf[r32]=f; resc=true; } } \
    SBAR(); \
    GAPB(o[0]=__builtin_amdgcn_mfma_f32_32x32x16_bf16(PAF(0),VFR(0),o[0],0,0,0), C0,0); \
    GAPB(o[1]=__builtin_amdgcn_mfma_f32_32x32x16_bf16(PAF(0),VFR(4),o[1],0,0,0), C0,4); \
    KRD(GL,0); GAPB(o[0]=__builtin_amdgcn_mfma_f32_32x32x16_bf16(PAF(1),VFR(1),o[0],0,0,0), C0,8); \
    KRD(GL,1); GAPB(o[1]=__builtin_amdgcn_mfma_f32_32x32x16_bf16(PAF(1),VFR(5),o[1],0,0,0), C0,12); \
    KRD(GL,2); GAPB(o[0]=__builtin_amdgcn_mfma_f32_32x32x16_bf16(PAF(2),VFR(2),o[0],0,0,0), C1,0); \
    KRD(GL,3); GAPB(o[1]=__builtin_amdgcn_mfma_f32_32x32x16_bf16(PAF(2),VFR(6),o[1],0,0,0), C1,4); \
    GAPB(o[0]=__builtin_amdgcn_mfma_f32_32x32x16_bf16(PAF(3),VFR(3),o[0],0,0,0), C1,8); \
    GAPB(o[1]=__builtin_amdgcn_mfma_f32_32x32x16_bf16(PAF(3),VFR(7),o[1],0,0,0), C1,12); \
    }while(0)
  int t=1;
  #undef CMASK
  #define CMASK(P0,P1,t) do{}while(0)
  for(;t+5<NT;t+=2){
    STEP(pB0,pB1,pA0,pA1,t,true,true,true);     WAIT_BAR(2); RESC(); ROT();
    STEP(pA0,pA1,pB0,pB1,t+1,true,true,true);   WAIT_BAR(2); RESC(); ROT();
  }
  #undef CMASK
  #define CMASK(P0,P1,t) do{int jb_=(t)-(NT-4); if(jb_>=0)cmask(P0,P1,jb_,qrel,hi);}while(0)
  #define ENDW(tt) do{ if((tt)+3<NT){WAIT_BAR(2);} else if((tt)+2<NT){WAIT_BAR(1);} else {WAIT_BAR(0);} }while(0)
  for(;t+1<NT;t+=2){
    STEP(pB0,pB1,pA0,pA1,t,(t+3<NT),(t+1<NT),(t+1<NT));       ENDW(t);   RESC(); ROT();
    STEP(pA0,pA1,pB0,pB1,t+1,(t+4<NT),(t+2<NT),(t+2<NT));     ENDW(t+1); RESC(); ROT();
  }
  STEP(pB0,pB1,pA0,pA1,NT-1,false,false,false); RESC();
  { float sacc=pB0[0]+pB0[1]; _Pragma("unroll") for(int r=2;r<16;++r)sacc+=pB0[r]; _Pragma("unroll") for(int r=0;r<16;++r)sacc+=pB1[r]; l_reg+=sacc;
    pw0=(u32x4){PKW(pB0,0),PKW(pB0,2),PKW(pB0,4),PKW(pB0,6)};pw1=(u32x4){PKW(pB0,8),PKW(pB0,10),PKW(pB0,12),PKW(pB0,14)};pw2=(u32x4){PKW(pB1,0),PKW(pB1,2),PKW(pB1,4),PKW(pB1,6)};pw3=(u32x4){PKW(pB1,8),PKW(pB1,10),PKW(pB1,12),PKW(pB1,14)};
    SBAR(); pv(o,vb0+sl_cur,PAF(0),PAF(1),PAF(2),PAF(3)); }
  #undef PKW
  #undef PAF
  #undef VFR
  #undef PIN
  #undef MX3
  #undef GAPA
  #undef GAPB
  #undef EX
  #undef VRD
  #undef KRD
  #undef STEP
  #undef ENDW
  {auto rr=__builtin_amdgcn_permlane32_swap(__float_as_uint(l_reg),__float_as_uint(l_reg),false,false);l_reg=__uint_as_float(rr[0])+__uint_as_float(rr[1]);}
  if(hi==0)wsf[32+r32]=l_reg;asm volatile("s_waitcnt lgkmcnt(0)":::"memory");
  float rli[16];
  #pragma unroll
  for(int r=0;r<16;++r)rli[r]=__builtin_amdgcn_rcpf(wsf[32+crow(r,hi)]);
  bf16*Ow=O+(rowbase+q0+wid*QBLK)*DM+hv*D;
  { bf16*stg=(bf16*)(shm+LDS_OST)+wid*2048;
    #pragma unroll
    for(int r=0;r<16;++r){const int orow=crow(r,hi);
      #pragma unroll
      for(int d0=0;d0<2;++d0)stg[orow*64+d0*32+r32]=__float2bfloat16(o[d0][r]*rli[r]);}
    asm volatile("s_waitcnt lgkmcnt(0)":::"memory");
    #pragma unroll
    for(int i=0;i<4;++i){const int row=i*8+(lane>>3),ch=lane&7; const u32x4 v=*(const u32x4*)(stg+row*64+ch*8); ATTN_STORE16(Ow+(long)row*DM+ch*8,v);} }
  asm volatile("s_waitcnt lgkmcnt(0)\n\ts_barrier":::"memory");
  #undef DMA_K
  #undef DMA_V
  #undef CMASK
  #undef START
  #undef RESC
  #undef ROT
}
constexpr int ATTN_LDS_BYTES=LDS_BYTES;
struct AttnTensors { const bf16* Q; const bf16* K; const bf16* V; bf16* O0; bf16* O1; };
struct AttnUnit { int b, hq, hv, m, qb; };
struct StaticOrder {
  int bx, G;
  __device__ __forceinline__ explicit StaticOrder(int grid,int block):bx(block),G(grid){}
  __device__ __forceinline__ bool next(int i,AttnUnit&u)const{
    int bh,sub,qb;
    if(G==256){ if(i>=8)return false; const int x=bx&7,j=bx>>3,s=j&7; bh=x*4+(i>>1); sub=j>>3; qb=(i&1)?15-s:s; }
    else { const int U=i*G+bx; if(U>=2048)return false; bh=U>>6; sub=(U>>4)&3; qb=15-(U&15); }
    u.b=bh>>3; const int h=bh&7; u.m=sub>>1; u.hq=h*2+u.m; u.hv=h*2+(sub&1); u.qb=qb; return true; }
  __device__ __forceinline__ void a_ready(const AttnUnit&)const{}
  __device__ __forceinline__ void done(const AttnUnit&)const{}
};
template<class Sched,int THRL=8> __device__ __forceinline__ void attn_phase(char*lds,const AttnTensors&T,const Sched&S){
  AttnUnit u;
  for(int i=0;S.next(i,u);++i){ S.a_ready(u); attn_unit<THRL>(u.b,u.hq,u.hv,u.qb,T.Q,T.K,T.V,u.m?T.O1:T.O0,lds); S.done(u); }
}
#undef SBAR
#undef WAIT_BAR
}
namespace attn2 {
using bf16 = __hip_bfloat16;
typedef short bf16x8 __attribute__((ext_vector_type(8)));
typedef short s16x4 __attribute__((ext_vector_type(4)));
typedef float f32x16 __attribute__((ext_vector_type(16)));
typedef unsigned u32x4 __attribute__((ext_vector_type(4)));
constexpr int SEQ = 4096, DK = 64, DV = 128, PITCH = 1024;
constexpr float SCALE = 0.125f, THR = 8.f;
constexpr int NW = 8, QBLK = 32, KVBLK = 64, QB = NW * QBLK;
constexpr int SHM_V = KVBLK * DV * 2, SHM_K = KVBLK * DK * 2;
constexpr int LDS_BYTES = 2 * SHM_V + 2 * SHM_K + NW * 64 * 4;
#define A2_KSWZ(row, colB) ((row) * 128 + ((colB) ^ ((((row) >> 1) & 7) << 4)))
#define A2_SBAR() __builtin_amdgcn_sched_barrier(0)
__device__ __forceinline__ int v_st(int k, int c) { const int kk = (k & ~0xC) | ((k & 4) << 1) | ((k & 8) >> 1); return ((kk >> 3) * 4 + (c >> 5)) * 512 + ((kk & 7) * 32 + (c & 31)) * 2; }
__device__ __forceinline__ int v_rd_base(int lane) { return ((lane & 3) << 3) | (((lane >> 2) & 3) << 6) | (((lane >> 4) & 1) << 5) | (((lane >> 5) & 1) << 8); }
constexpr int v_rd_off(int d0, int ks, int half) { return d0 * 512 + ks * 4096 + half * 2048; }
__device__ __forceinline__ int crow(int r, int hi) { return (r & 3) + 8 * (r >> 2) + 4 * hi; }
__device__ __forceinline__ unsigned cvtpk(float lo, float hi) { unsigned r; asm volatile("v_cvt_pk_bf16_f32 %0, %1, %2" : "=v"(r) : "v"(lo), "v"(hi)); return r; }
__device__ __forceinline__ bf16x8 load8(const bf16* p) { return *reinterpret_cast<const bf16x8*>(p); }
__device__ __forceinline__ void mask_tile(f32x16& p0, f32x16& p1, int dq) {
    const float NEG = -__builtin_inff();
#pragma unroll
    for (int r = 0; r < 16; ++r) { const int c = (r & 3) + 8 * (r >> 2);
        if (dq - c < 0) p0[r] = NEG;
        if (dq - c - 32 < 0) p1[r] = NEG; }
}
constexpr float THR2 = THR * 1.4426950408889634f;
__device__ __forceinline__ float rowmax32(const f32x16& p0, const f32x16& p1) {
    float pmax = p0[0]; for (int r = 1; r < 16; ++r) pmax = fmaxf(pmax, p0[r]); for (int r = 0; r < 16; ++r) pmax = fmaxf(pmax, p1[r]);
    auto rr = __builtin_amdgcn_permlane32_swap(__float_as_uint(pmax), __float_as_uint(pmax), false, false);
    return fmaxf(__uint_as_float(rr[0]), __uint_as_float(rr[1]));
}
__device__ __forceinline__ void partialSM_first(f32x16& p0, f32x16& p1, f32x16& negm, float& alpha) {
    const float pmax = rowmax32(p0, p1);
    for (int r = 0; r < 16; ++r) { p0[r] -= pmax; p1[r] -= pmax; }
    for (int r = 0; r < 16; ++r) negm[r] = -pmax;
    asm volatile("" : "+v"(negm));
    alpha = 1.f;
    for (int r = 0; r < 16; ++r) p0[r] = __builtin_amdgcn_exp2f(p0[r]);
}
__device__ __forceinline__ void psm_decide(f32x16& p0, f32x16& p1, f32x16& negm, float pmax, float& alpha) {
    if (__builtin_expect(__all(pmax <= THR2), 1)) { alpha = 1.f; }
    else { const float dl = fmaxf(pmax, 0.f); alpha = __builtin_amdgcn_exp2f(-dl);
        for (int r = 0; r < 16; ++r) { p0[r] -= dl; p1[r] -= dl; }
        for (int r = 0; r < 16; ++r) negm[r] -= dl;
        asm volatile("" : "+v"(negm)); }
}
__device__ __forceinline__ void partialSM_n(f32x16& p0, f32x16& p1, f32x16& negm, float& alpha) {
    psm_decide(p0, p1, negm, rowmax32(p0, p1), alpha);
    for (int r = 0; r < 16; ++r) p0[r] = __builtin_amdgcn_exp2f(p0[r]);
}
__device__ __forceinline__ void finishSM(f32x16& p0, f32x16& p1, float alpha, float& l_reg, bf16x8& pa0, bf16x8& pa1, bf16x8& pa2, bf16x8& pa3) {
    for (int r = 0; r < 16; ++r) p1[r] = __builtin_amdgcn_exp2f(p1[r]);
    float ps = 0; for (int r = 0; r < 16; ++r) ps += p0[r]; for (int r = 0; r < 16; ++r) ps += p1[r];
    { auto rr = __builtin_amdgcn_permlane32_swap(__float_as_uint(ps), __float_as_uint(ps), false, false);
      ps = __uint_as_float(rr[0]) + __uint_as_float(rr[1]); }
    l_reg = l_reg * alpha + ps;
#define A2_PK4(P, B_, OUT) do { unsigned a0 = cvtpk(P[B_+0], P[B_+1]), a1 = cvtpk(P[B_+2], P[B_+3]);                          \
        unsigned b0 = cvtpk(P[B_+4], P[B_+5]), b1 = cvtpk(P[B_+6], P[B_+7]);                                             \
        auto r0 = __builtin_amdgcn_permlane32_swap(a0, b0, false, false); auto r1 = __builtin_amdgcn_permlane32_swap(a1, b1, false, false); \
        u32x4 w = {r0[0], r1[0], r0[1], r1[1]}; OUT = *reinterpret_cast<bf16x8*>(&w); } while (0)
    A2_PK4(p0, 0, pa0); A2_PK4(p0, 8, pa1); A2_PK4(p1, 0, pa2); A2_PK4(p1, 8, pa3);
#undef A2_PK4
}
template <int KB>
__device__ __forceinline__ void qkt(f32x16& p0, f32x16& p1, const char* K_lds, int r32, int hi, const bf16x8* qr, const f32x16& cinit) {
    p0 = cinit; p1 = cinit;
#pragma unroll
    for (int d0 = 0; d0 < 4; ++d0) { const char* a = K_lds + KB * SHM_K + A2_KSWZ(r32, (d0 * 16 + hi * 8) * 2);
        bf16x8 b0 = *reinterpret_cast<const bf16x8*>(a);
        bf16x8 b1 = *reinterpret_cast<const bf16x8*>(a + 32 * 128);
        p0 = __builtin_amdgcn_mfma_f32_32x32x16_bf16(b0, qr[d0], p0, 0, 0, 0);
        p1 = __builtin_amdgcn_mfma_f32_32x32x16_bf16(b1, qr[d0], p1, 0, 0, 0); }
}
template <int VB>
__device__ __forceinline__ void pv_tile(f32x16* o, int vb0, bf16x8 pa0, bf16x8 pa1, bf16x8 pa2, bf16x8 pa3) {
#define A2_TRRD(dst, off) asm volatile("ds_read_b64_tr_b16 %0, %1 offset:%2" : "=&v"(dst) : "v"(vb0), "i"(off) : "memory")
#define A2_PV_D0(ks) do { s16x4 l0, l1, l2, l3, h0, h1, h2, h3; constexpr int b_ = VB * SHM_V + v_rd_off(0, ks, 0);     \
        A2_TRRD(l0, b_); A2_TRRD(h0, b_ + 2048); A2_TRRD(l1, b_ + 512); A2_TRRD(h1, b_ + 512 + 2048); A2_TRRD(l2, b_ + 1024); A2_TRRD(h2, b_ + 1024 + 2048); A2_TRRD(l3, b_ + 1536); A2_TRRD(h3, b_ + 1536 + 2048); \
        asm volatile("s_waitcnt lgkmcnt(0)" ::: "memory"); A2_SBAR();   \
        { const bf16x8 pk_ = (ks) == 0 ? pa0 : (ks) == 1 ? pa1 : (ks) == 2 ? pa2 : pa3;     \
        o[0] = __builtin_amdgcn_mfma_f32_32x32x16_bf16(pk_, (bf16x8){l0[0], l0[1], l0[2], l0[3], h0[0], h0[1], h0[2], h0[3]}, o[0], 0, 0, 0);   \
        o[1] = __builtin_amdgcn_mfma_f32_32x32x16_bf16(pk_, (bf16x8){l1[0], l1[1], l1[2], l1[3], h1[0], h1[1], h1[2], h1[3]}, o[1], 0, 0, 0);   \
        o[2] = __builtin_amdgcn_mfma_f32_32x32x16_bf16(pk_, (bf16x8){l2[0], l2[1], l2[2], l2[3], h2[0], h2[1], h2[2], h2[3]}, o[2], 0, 0, 0);   \
        o[3] = __builtin_amdgcn_mfma_f32_32x32x16_bf16(pk_, (bf16x8){l3[0], l3[1], l3[2], l3[3], h3[0], h3[1], h3[2], h3[3]}, o[3], 0, 0, 0); } } while (0)
    A2_PV_D0(0); A2_PV_D0(1); A2_PV_D0(2); A2_PV_D0(3);
#undef A2_PV_D0
#undef A2_TRRD
}
template <int VB>
__device__ __forceinline__ void pv_psm(f32x16* o, int vb0, bf16x8 pa0, bf16x8 pa1, bf16x8 pa2, bf16x8 pa3, f32x16& p0, f32x16& p1, f32x16& negm, float& alpha) {
#define A2_TRRD(dst, off) asm volatile("ds_read_b64_tr_b16 %0, %1 offset:%2" : "=&v"(dst) : "v"(vb0), "i"(off) : "memory")
#define A2_PV_D0(ks) do { s16x4 l0, l1, l2, l3, h0, h1, h2, h3; constexpr int b_ = VB * SHM_V + v_rd_off(0, ks, 0);     \
        A2_TRRD(l0, b_); A2_TRRD(h0, b_ + 2048); A2_TRRD(l1, b_ + 512); A2_TRRD(h1, b_ + 512 + 2048); A2_TRRD(l2, b_ + 1024); A2_TRRD(h2, b_ + 1024 + 2048); A2_TRRD(l3, b_ + 1536); A2_TRRD(h3, b_ + 1536 + 2048); \
        asm volatile("s_waitcnt lgkmcnt(0)" ::: "memory"); A2_SBAR();   \
        { const bf16x8 pk_ = (ks) == 0 ? pa0 : (ks) == 1 ? pa1 : (ks) == 2 ? pa2 : pa3;     \
        o[0] = __builtin_amdgcn_mfma_f32_32x32x16_bf16(pk_, (bf16x8){l0[0], l0[1], l0[2], l0[3], h0[0], h0[1], h0[2], h0[3]}, o[0], 0, 0, 0);   \
        o[1] = __builtin_amdgcn_mfma_f32_32x32x16_bf16(pk_, (bf16x8){l1[0], l1[1], l1[2], l1[3], h1[0], h1[1], h1[2], h1[3]}, o[1], 0, 0, 0);   \
        o[2] = __builtin_amdgcn_mfma_f32_32x32x16_bf16(pk_, (bf16x8){l2[0], l2[1], l2[2], l2[3], h2[0], h2[1], h2[2], h2[3]}, o[2], 0, 0, 0);   \
        o[3] = __builtin_amdgcn_mfma_f32_32x32x16_bf16(pk_, (bf16x8){l3[0], l3[1], l3[2], l3[3], h3[0], h3[1], h3[2], h3[3]}, o[3], 0, 0, 0); } } while (0)
    A2_PV_D0(0);
    float pmax = p0[0]; for (int r = 1; r < 16; ++r) pmax = fmaxf(pmax, p0[r]);
    A2_PV_D0(1);
    for (int r = 0; r < 16; ++r) pmax = fmaxf(pmax, p1[r]);
    { auto rr = __builtin_amdgcn_permlane32_swap(__float_as_uint(pmax), __float_as_uint(pmax), false, false);
      pmax = fmaxf(__uint_as_float(rr[0]), __uint_as_float(rr[1])); }
    psm_decide(p0, p1, negm, pmax, alpha);
    A2_PV_D0(2);
    for (int r = 0; r < 8; ++r) p0[r] = __builtin_amdgcn_exp2f(p0[r]);
    asm volatile("" : "+v"(p0));
    A2_PV_D0(3);
    for (int r = 8; r < 16; ++r) p0[r] = __builtin_amdgcn_exp2f(p0[r]);
    asm volatile("" : "+v"(p0));
#undef A2_PV_D0
#undef A2_TRRD
}
struct BlockRef { const bf16* Q; const bf16* K; const bf16* V; bf16* O; int P0; };
struct Seam { bf16x8 qr[4]; bf16x8 st_v0, st_v1, st_k0; };
#define A2_VMW() asm volatile("s_waitcnt vmcnt(0)" ::: "memory")
#define A2_VMWN(n) asm volatile("s_waitcnt vmcnt(%0)" :: "i"(n) : "memory")
#define A2_SLOAD(Kp, Vp, k0) do { S.st_v0 = load8((Vp) + (size_t)((k0) + vsr) * PITCH + vsc); S.st_v1 = load8((Vp) + (size_t)((k0) + 32 + vsr) * PITCH + vsc); \
                                  S.st_k0 = load8((Kp) + (size_t)((k0) + ksr) * PITCH + ksc); } while (0)
#define A2_SWRITE_K(bf) do { *(bf16x8*)(K_lds + (bf) * SHM_K + kws) = S.st_k0; } while (0)
#define A2_SWRITE_V(bf) do { *(bf16x8*)(V_lds + (bf) * SHM_V + vst0) = S.st_v0; *(bf16x8*)(V_lds + (bf) * SHM_V + vst1) = S.st_v1; } while (0)
__device__ __forceinline__ void prime(const BlockRef& cur, char* lds, Seam& S) {
    int tid_ = threadIdx.x; asm volatile("" : "+v"(tid_));
    const int tid = tid_, wid = __builtin_amdgcn_readfirstlane(tid >> 6), lane = tid & 63, r32 = lane & 31, hi = lane >> 5;
    const int vsr = tid >> 4, vsc = (tid & 15) * 8, ksr = tid >> 3, ksc = (tid & 7) * 8, kws = A2_KSWZ(ksr, ksc * 2); char* K_lds = lds + 2 * SHM_V;
#pragma unroll
    for (int d0 = 0; d0 < 4; ++d0) S.qr[d0] = load8(cur.Q + (size_t)(wid * QBLK + r32) * PITCH + d0 * 16 + hi * 8);
    A2_SLOAD(cur.K, cur.V, 0); A2_VMW(); A2_SWRITE_K(0);
    __syncthreads();
}
__device__ __forceinline__ void block(const BlockRef& cur, const BlockRef& nxt, char* lds, Seam& S) {
    int tid_ = threadIdx.x; asm volatile("" : "+v"(tid_));
    const int tid = tid_, wid = __builtin_amdgcn_readfirstlane(tid >> 6), lane = tid & 63, r32 = lane & 31, hi = lane >> 5;
    const int NT = (cur.P0 + QB) / KVBLK;
    const int qe = (cur.P0 + wid * QBLK) | 63, qm = qe - 4 * hi;
    char* V_lds = lds; char* K_lds = lds + 2 * SHM_V;
    float* ws = (float*)(lds + 2 * SHM_V + 2 * SHM_K) + wid * 64; float* li_l = ws, * al_l = ws + 32;
    float l_reg = 0; f32x16 o[4] = {}; f32x16 negm = {};
    const int vsr = tid >> 4, vsc = (tid & 15) * 8, vst0 = v_st(vsr, vsc), vst1 = v_st(32 + vsr, vsc), ksr = tid >> 3, ksc = (tid & 7) * 8, kws = A2_KSWZ(ksr, ksc * 2);
    const int vb0 = (int)(uintptr_t)V_lds + v_rd_base(lane);
    const bf16* kq = cur.K + (size_t)(KVBLK + ksr) * PITCH + ksc; const bf16* vq0 = cur.V + (size_t)(KVBLK + vsr) * PITCH + vsc; const bf16* vq1 = vq0 + (size_t)32 * PITCH;
#define A2_SLOADN() do { S.st_v0 = load8(vq0); S.st_v1 = load8(vq1); S.st_k0 = load8(kq); vq0 += (size_t)KVBLK * PITCH; vq1 += (size_t)KVBLK * PITCH; kq += (size_t)KVBLK * PITCH; } while (0)
#define A2_RESC(a) do { if (__any((a) < 1.f)) { if (hi == 0) al_l[r32] = (a); asm volatile("s_waitcnt lgkmcnt(0)" ::: "memory");              \
                     for (int d_ = 0; d_ < 4; ++d_) for (int r = 0; r < 16; ++r) o[d_][r] *= al_l[crow(r, hi)]; } } while (0)
#define A2_KBASE(t) ((t) * KVBLK)
#define A2_MASKT(P0_, P1_, t) do { const int kb_ = A2_KBASE(t); if (kb_ + KVBLK - 1 > qe) mask_tile(P0_, P1_, qm - kb_); } while (0)
    constexpr int NQL = 4;
#define A2_SEAM_K0() do { A2_VMWN(NQL); A2_SWRITE_K(0); A2_SBAR(); } while (0)
    f32x16 pA0, pA1, pB0, pB1; float alA, alB; bf16x8 pa0, pa1, pa2, pa3;
    A2_SWRITE_V(0); A2_SBAR();
    if (NT > 1) A2_SLOADN();
    A2_SBAR(); qkt<0>(pA0, pA1, K_lds, r32, hi, S.qr, negm);
    partialSM_first(pA0, pA1, negm, alA);
    if (NT > 1) { A2_VMW(); A2_SWRITE_V(1); A2_SWRITE_K(1); }
    __syncthreads();
#define A2_HALF_STEP(PX0, PX1, alX, PY0, PY1, alY, t, KB, VB, SB) do {                                                      \
        A2_SBAR(); if ((t) + 1 < NT) { A2_SLOADN(); A2_SBAR(); }     \
        qkt<KB>(PX0, PX1, K_lds, r32, hi, S.qr, negm);                                                                               \
        finishSM(PY0, PY1, alY, l_reg, pa0, pa1, pa2, pa3); A2_SBAR();                                                           \
        A2_MASKT(PX0, PX1, (t)); pv_psm<VB>(o, vb0, pa0, pa1, pa2, pa3, PX0, PX1, negm, alX);                              \
        __syncthreads();                                                                                                      \
        if ((t) + 1 < NT) { A2_VMW(); A2_SWRITE_V(SB); A2_SWRITE_K(SB); }                                                      \
        A2_RESC(alX); __syncthreads(); } while (0)
    for (int t = 1; t + 1 < NT; t += 2) {
        A2_HALF_STEP(pB0, pB1, alB, pA0, pA1, alA, t, 1, 0, 0);
        A2_HALF_STEP(pA0, pA1, alA, pB0, pB1, alB, t + 1, 0, 1, 1);
    }
    A2_SBAR(); qkt<1>(pB0, pB1, K_lds, r32, hi, S.qr, negm); A2_SBAR();
    A2_SLOAD(nxt.K, nxt.V, 0); A2_SBAR();
#pragma unroll
    for (int d0 = 0; d0 < 4; ++d0) S.qr[d0] = load8(nxt.Q + (size_t)(wid * QBLK + r32) * PITCH + d0 * 16 + hi * 8);
    A2_SBAR();
    finishSM(pA0, pA1, alA, l_reg, pa0, pa1, pa2, pa3); A2_SBAR();
    pv_tile<0>(o, vb0, pa0, pa1, pa2, pa3);
    A2_MASKT(pB0, pB1, NT - 1); partialSM_n(pB0, pB1, negm, alB); __syncthreads(); A2_RESC(alB);
    finishSM(pB0, pB1, alB, l_reg, pa0, pa1, pa2, pa3); A2_SBAR(); pv_tile<1>(o, vb0, pa0, pa1, pa2, pa3);
    A2_SBAR(); A2_SEAM_K0();
    if (hi == 0) li_l[r32] = l_reg; asm volatile("s_waitcnt lgkmcnt(0)" ::: "memory");
    float rli[16];
#pragma unroll
    for (int r = 0; r < 16; ++r) rli[r] = __builtin_amdgcn_rcpf(li_l[crow(r, hi)]);
    bf16* Ow = cur.O + (size_t)(wid * QBLK) * PITCH;
#pragma unroll
    for (int r = 0; r < 16; ++r) { const int orow = crow(r, hi);
#pragma unroll
        for (int d0 = 0; d0 < 4; ++d0) { const float v = o[d0][r] * rli[r];
            const float vn = __shfl_xor(v, 1);
            if ((r32 & 1) == 0) *(unsigned*)(Ow + (size_t)orow * PITCH + d0 * 32 + r32) = cvtpk(v, vn); } }
    __syncthreads();
#undef A2_RESC
#undef A2_KBASE
#undef A2_MASKT
#undef A2_SEAM_K0
#undef A2_HALF_STEP
#undef A2_SLOADN
}
#undef A2_VMW
#undef A2_VMWN
#undef A2_SLOAD
#undef A2_SWRITE_K
#undef A2_SWRITE_V
struct Tensors { const bf16* Q; const bf16* K; const bf16* V; bf16* O0; bf16* O1; };
__device__ __forceinline__ bool item(int i, int G, int bx, int& triple, int& qb) {
    if (G == 256) { if (i >= 4) return false; const int x = bx & 7, j = bx >> 3, s = j & 7, k = i >> 1; triple = 8 * x + 4 * k + (j >> 3); qb = (i & 1) ? 15 - s : s; return true; }
    const int U = i * G + bx; if (U >= 1024) return false; triple = U >> 4; qb = 15 - (U & 15); return true;
}
__device__ __forceinline__ BlockRef ref(const Tensors& T, int triple, int qb) {
    const int bh = triple >> 1, m = triple & 1, b = bh >> 3, h = bh & 7; const size_t row0 = (size_t)b * SEQ;
    BlockRef r; r.Q = T.Q + (row0 + (size_t)qb * QB) * PITCH + (h * 2 + m) * DK; r.K = T.K + row0 * PITCH + (h * 2 + m) * DK; r.V = T.V + row0 * PITCH + h * DV;
    r.O = (m ? T.O1 : T.O0) + (row0 + (size_t)qb * QB) * PITCH + h * DV; r.P0 = qb * QB; return r;
}
__device__ __forceinline__ void phase(char* lds, const Tensors& T, int G, int bx) {
    int triple, qb; if (!item(0, G, bx, triple, qb)) return;
    BlockRef cur = ref(T, triple, qb);
    Seam S; prime(cur, lds, S);
    for (int i = 0;; ++i) {
        int tn, qn; const bool more = item(i + 1, G, bx, tn, qn);
        const BlockRef nxt = more ? ref(T, tn, qn) : cur;
        block(cur, nxt, lds, S);
        if (!more) break;
        cur = nxt;
    }
}
#undef A2_KSWZ
#undef A2_SBAR
}

namespace cg = cooperative_groups;
constexpr int NWAVES = 8;
#ifndef ATTN_V128
#define ATTN_V128 1
#endif
#ifndef MK_MULTI
#define MK_MULTI 0
#endif
constexpr int NB = 4, S = 4096, D = 2048, DEPTH = 4, M = NB * S, DIN = 6144, NHEADS = 8;
constexpr float EPS = 1e-6f;
constexpr int N_PHASES = 2 + 5 * DEPTH;
constexpr size_t MiB = 1u << 20;
constexpr size_t WS_WIN = 2 * MiB;
constexpr size_t WS_WOUT = 98 * MiB;
constexpr size_t WS_WPOOL = 130 * MiB;
constexpr size_t WS_H = 132 * MiB;
constexpr size_t WS_Z = 196 * MiB;
constexpr size_t WS_O = 388 * MiB;
constexpr size_t WS_POOLED = 452 * MiB;
constexpr size_t WS_MIX = 484 * MiB;
constexpr size_t WS_Y = 548 * MiB;
constexpr size_t WS_ADA = 612 * MiB;
constexpr size_t WS_ROPE = 620 * MiB;
constexpr size_t WS_X16 = 624 * MiB;
constexpr size_t WS_END = 688 * MiB;
constexpr size_t ZSTRIDE = (size_t)M * 1024;
constexpr int ADA_KS = 16;
constexpr int RING_BYTES = 131072, LDS_BYTES = 147456, MISC_OFF = RING_BYTES + 320;
constexpr size_t WS_CTL = 0, CTL_ZERO_BYTES = 65536; constexpr int CW_BAR = 4096;

#define LAS __attribute__((address_space(3)))
typedef unsigned short bf16;
typedef unsigned v4u __attribute__((ext_vector_type(4)));
typedef unsigned v2u __attribute__((ext_vector_type(2)));
typedef float f32x4 __attribute__((ext_vector_type(4)));
#define LDS_WAIT() asm volatile("s_waitcnt lgkmcnt(0)" ::: "memory")
__device__ __forceinline__ unsigned f2bf(float f) { unsigned u = __builtin_bit_cast(unsigned, f); return (u + 0x7fffu + ((u >> 16) & 1u)) >> 16; }
__device__ __forceinline__ unsigned pk2(float lo, float hi) { return f2bf(lo) | (f2bf(hi) << 16); }
__device__ __forceinline__ float wave_sum(float v) {
#pragma unroll
    for (int o = 1; o < 64; o <<= 1) v += __shfl_xor(v, o);
    return v;
}

struct Frame { LAS unsigned char* lds; int tid, lane, wave, vcu, G; };
__device__ __forceinline__ Frame make_frame(unsigned char* lds_generic) {
    Frame F; F.lds = (LAS unsigned char*)lds_generic;
    int tid = threadIdx.x; asm volatile("" : "+v"(tid)); int bx = blockIdx.x; asm volatile("" : "+s"(bx)); int G = gridDim.x; asm volatile("" : "+s"(G));
    F.tid = tid; F.lane = tid & 63; F.wave = __builtin_amdgcn_readfirstlane(tid >> 6); F.G = G; F.vcu = (G % 8 == 0) ? (bx % 8) * (G / 8) + bx / 8 : bx;
    return F;
}
typedef const unsigned char __attribute__((address_space(4)))* kptr_t;
__device__ __forceinline__ int opaque_bx() { int bx = blockIdx.x; asm volatile("" : "+s"(bx)); return bx; }
__device__ __forceinline__ int opaque_G() { int G = gridDim.x; asm volatile("" : "+s"(G)); return G; }
__device__ __forceinline__ kptr_t kargs_opaque() { kptr_t p = (kptr_t)__builtin_amdgcn_kernarg_segment_ptr(); asm volatile("" : "+s"(p)); return p; }
template <class T> __device__ __forceinline__ T* karg(kptr_t kp, int idx) { return *(T* const __attribute__((address_space(4)))*)(kp + 8 * idx); }
enum { A_X = 0, A_C, A_POS, A_WADA, A_BADA, A_GPRE, A_WIN, A_WPOOL, A_PSCALE, A_LQ1, A_LK1, A_LQ2, A_LK2, A_SUBLN, A_WOUT, A_GPOST, A_OUT, A_WS };
#define WSP(T, off) ((T*)(karg<unsigned char>(kp, A_WS) + (off)))

__device__ __forceinline__ int inmap(int n) { if (n < 2048 || n >= 4096) return n; const int p = n & 63, g = p >> 3, j = p & 7; return (n & ~63) + ((j < 4) ? 4 * g + j : 32 + 4 * g + (j - 4)); }

struct TItem { const float* src; size_t nstride; bf16* dst; int K; };
__device__ __forceinline__ TItem t_decode(int it, int lane, const float* w_in, const float* w_out, const float* w_pool, bf16* Win_t, bf16* Wout_t, bf16* Wpool_t) {
    constexpr int I_IN = (D / 64) * (DIN / 32), I_OUT = (D / 64) * (D / 32), I_PG = (256 / 64) * (256 / 32), I_LAYER = I_IN + I_OUT + 4 * I_PG;
    const int l = it / I_LAYER; int r = it % I_LAYER;
    const float* W; bf16* WT; int K, N; bool perm = false;
    if (r < I_IN) { W = w_in + (size_t)l * D * DIN; WT = Win_t + (size_t)l * DIN * D; K = D; N = DIN; perm = true; }
    else if (r < I_IN + I_OUT) { r -= I_IN; W = w_out + (size_t)l * D * D; WT = Wout_t + (size_t)l * D * D; K = D; N = D; }
    else { r -= I_IN + I_OUT; const int g = r / I_PG; r %= I_PG; W = w_pool + (size_t)(l * 4 + g) * 65536; WT = Wpool_t + (size_t)(l * 4 + g) * 65536; K = 256; N = 256; }
    const int nblk = N / 32, kb = r / nblk, nb = r % nblk, k0 = 64 * kb, n0 = 32 * nb;
    const int srcn = perm ? inmap(n0 + (lane & 31)) : n0 + (lane & 31);
    TItem t; t.src = W + (size_t)(k0 + (lane >> 5)) * N + srcn; t.nstride = (size_t)N; t.dst = WT + (size_t)n0 * K + k0; t.K = K; return t;
}
__device__ __forceinline__ void t_load(const TItem& t, float (&v)[32]) {
#pragma unroll
    for (int i = 0; i < 32; ++i) v[i] = t.src[(size_t)(2 * i) * t.nstride];
}
__device__ __forceinline__ void t_store(const TItem& t, const float (&v)[32], LAS float* scr, int lane) {
#pragma unroll
    for (int i = 0; i < 32; ++i) scr[(2 * i + (lane >> 5)) * 33 + (lane & 31)] = v[i];
    LDS_WAIT(); asm volatile("" ::: "memory");
    const int c = lane & 7;
#pragma unroll
    for (int j = 0; j < 4; ++j) { const int n = (lane >> 3) + 8 * j; const LAS float* s = scr + (8 * c) * 33 + n;
        v4u o; o.x = pk2(s[0 * 33], s[1 * 33]); o.y = pk2(s[2 * 33], s[3 * 33]); o.z = pk2(s[4 * 33], s[5 * 33]); o.w = pk2(s[6 * 33], s[7 * 33]);
        *(v4u*)(t.dst + (size_t)n * t.K + 8 * c) = o; }
    LDS_WAIT(); asm volatile("" ::: "memory");
}

__device__ __forceinline__ void phase_prologue(unsigned char* lds_) {
    Frame F = make_frame(lds_);
    const kptr_t kp = kargs_opaque();
    const float* w_in = karg<const float>(kp, A_WIN); const float* w_out = karg<const float>(kp, A_WOUT); const float* w_pool = karg<const float>(kp, A_WPOOL);
    bf16* Win_t = WSP(bf16, WS_WIN); bf16* Wout_t = WSP(bf16, WS_WOUT); bf16* Wpool_t = WSP(bf16, WS_WPOOL);
    LAS float* scr = (LAS float*)(F.lds + F.wave * 16384);
    const int gw = F.vcu * NWAVES + F.wave, NGW = F.G * NWAVES;
    {
        constexpr int I_LAYER = (D / 64) * (DIN / 32) + (D / 64) * (D / 32) + 4 * (256 / 64) * (256 / 32), NIT = DEPTH * I_LAYER;
        float va[32], vb[32];
        int it = gw;
        TItem ta = t_decode(it < NIT ? it : 0, F.lane, w_in, w_out, w_pool, Win_t, Wout_t, Wpool_t), tb = ta;
        if (it < NIT) t_load(ta, va);
        while (it < NIT) {
            const int it2 = it + NGW;
            if (it2 < NIT) { tb = t_decode(it2, F.lane, w_in, w_out, w_pool, Win_t, Wout_t, Wpool_t); t_load(tb, vb); }
            t_store(ta, va, scr, F.lane);
            if (it2 >= NIT) break;
            const int it3 = it2 + NGW;
            if (it3 < NIT) { ta = t_decode(it3, F.lane, w_in, w_out, w_pool, Win_t, Wout_t, Wpool_t); t_load(ta, va); }
            t_store(tb, vb, scr, F.lane);
            it = it3;
        }
    }
    constexpr int KSL = D / ADA_KS;
    const float* w_ada = karg<const float>(kp, A_WADA); const float* cvec = karg<const float>(kp, A_C); float* ADA = WSP(float, WS_ADA);
    for (int it = gw; it < DEPTH * ADA_KS * 24; it += NGW) {
        const int cb = it % 24, ks = (it / 24) % ADA_KS, l = it / (24 * ADA_KS);
        const float* w = w_ada + ((size_t)l * D + ks * KSL) * DIN + cb * 256 + F.lane * 4;
        const float* cc = cvec + ks * KSL;
        f32x4 a0 = {0.f, 0.f, 0.f, 0.f}, a1 = a0, a2 = a0, a3 = a0;
#pragma unroll 16
        for (int k = 0; k < KSL; ++k) { const f32x4 wv = *(const f32x4*)(w + (size_t)k * DIN);
            a0 += wv * cc[k]; a1 += wv * cc[D + k]; a2 += wv * cc[2 * D + k]; a3 += wv * cc[3 * D + k]; }
        float* o = ADA + ((size_t)(ks * DEPTH + l) * NB) * DIN + cb * 256 + F.lane * 4;
        *(f32x4*)(o) = a0; *(f32x4*)(o + DIN) = a1; *(f32x4*)(o + 2 * DIN) = a2; *(f32x4*)(o + 3 * DIN) = a3;
    }
    const int* pos = karg<const int>(kp, A_POS); float* COS = WSP(float, WS_ROPE); float* SIN = COS + (size_t)M * 32;
    for (int idx = F.vcu * 512 + F.tid; idx < M * 32; idx += F.G * 512) {
        const int t = idx >> 5, i = idx & 31;
        const float inv_freq = (float)exp2(-(double)i * (13.287712379549449 / 32.0));
        const float ang = (float)pos[t] * inv_freq;
        double rev = (double)ang * 0.15915494309189535; rev -= floor(rev);
        COS[idx] = __builtin_amdgcn_cosf((float)rev); SIN[idx] = __builtin_amdgcn_sinf((float)rev);
    }
}

#ifndef RP
#define RP 2
#endif
template <bool HAS_Y, bool HAS_H, bool XIN32, bool XOUT32>
__device__ __forceinline__ void phase_rowpass(unsigned char* lds_, int lpost, int lpre) {
    Frame F = make_frame(lds_);
    const kptr_t kp = kargs_opaque();
    float* xout = karg<float>(kp, A_OUT); const float* xin = karg<const float>(kp, A_X); bf16* X16 = WSP(bf16, WS_X16);
    const float* b_ada = karg<const float>(kp, A_BADA); const float* g_post = karg<const float>(kp, A_GPOST); const float* g_pre = karg<const float>(kp, A_GPRE);
    const float* ADA = WSP(const float, WS_ADA); const bf16* Y = WSP(const bf16, WS_Y); bf16* H = WSP(bf16, WS_H);
    LAS float* vA = (LAS float*)F.lds; LAS float* vB = vA + D; LAS float* vC = vB + D;
    for (int chunk = blockIdx.x; chunk < M / 64; chunk += F.G) {
        const int b = chunk >> 6;
        {
            const Frame Mf = make_frame(lds_); const unsigned j0 = (unsigned)Mf.tid * 4u;
            if (HAS_Y) { f32x4 g = *(const f32x4*)(b_ada + (size_t)lpost * DIN + 2 * D + j0);
                for (int ks = 0; ks < ADA_KS; ++ks) g += *(const f32x4*)(ADA + ((size_t)(ks * DEPTH + lpost) * NB + b) * DIN + 2 * D + j0);
                const f32x4 gp = *(const f32x4*)(g_post + (size_t)lpost * D + j0);
                *(LAS f32x4*)(vA + j0) = (g + 1.0f) * gp; }
            if (HAS_H) { f32x4 sh = *(const f32x4*)(b_ada + (size_t)lpre * DIN + j0), sc = *(const f32x4*)(b_ada + (size_t)lpre * DIN + D + j0);
                for (int ks = 0; ks < ADA_KS; ++ks) { const float* p = ADA + ((size_t)(ks * DEPTH + lpre) * NB + b) * DIN + j0; sh += *(const f32x4*)p; sc += *(const f32x4*)(p + D); }
                const f32x4 gp = *(const f32x4*)(g_pre + (size_t)lpre * D + j0);
                *(LAS f32x4*)(vB + j0) = (sc + 1.0f) * gp; *(LAS f32x4*)(vC + j0) = sh; }
        }
        __syncthreads();
        const Frame R = make_frame(lds_);
        const unsigned lo4 = (unsigned)R.lane * 4u;
        for (int i = 0; i < 8 / RP; ++i) {
            const size_t r0 = (size_t)chunk * 64 + R.wave * 8 + RP * i;
            f32x4 xv[RP][8]; v2u yw[RP][8];
#pragma unroll
            for (int p = 0; p < RP; ++p)
#pragma unroll
                for (int j = 0; j < 8; ++j) {
                    if (XIN32) xv[p][j] = *(const f32x4*)(xin + (r0 + p) * D + j * 256 + lo4);
                    else { const v2u w = *(const v2u*)(X16 + (r0 + p) * D + j * 256 + lo4);
                        xv[p][j] = (f32x4){__uint_as_float(w.x << 16), __uint_as_float(w.x & 0xffff0000u), __uint_as_float(w.y << 16), __uint_as_float(w.y & 0xffff0000u)}; }
                    if (HAS_Y) yw[p][j] = *(const v2u*)(Y + (r0 + p) * D + j * 256 + lo4); }
#pragma unroll
            for (int p = 0; p < RP; ++p) {
                const size_t r = r0 + p;
                if (HAS_Y) {
                    f32x4 yv[8]; float ss = 0.f;
#pragma unroll
                    for (int j = 0; j < 8; ++j) { const v2u w = yw[p][j];
                        yv[j] = (f32x4){__uint_as_float(w.x << 16), __uint_as_float(w.x & 0xffff0000u), __uint_as_float(w.y << 16), __uint_as_float(w.y & 0xffff0000u)};
                        ss += (yv[j].x * yv[j].x + yv[j].y * yv[j].y) + (yv[j].z * yv[j].z + yv[j].w * yv[j].w); }
                    const float ry = 1.0f / sqrtf(wave_sum(ss) * (1.0f / D) + EPS);
#pragma unroll
                    for (int j = 0; j < 8; ++j) { const f32x4 a = *(const LAS f32x4*)(vA + j * 256 + lo4); xv[p][j] += a * (yv[j] * ry);
                        if (XOUT32) *(f32x4*)(xout + r * D + j * 256 + lo4) = xv[p][j];
                        else { v2u w; w.x = pk2(xv[p][j].x, xv[p][j].y); w.y = pk2(xv[p][j].z, xv[p][j].w); *(v2u*)(X16 + r * D + j * 256 + lo4) = w; } }
                }
                if (HAS_H) {
                    float ss = 0.f;
#pragma unroll
                    for (int j = 0; j < 8; ++j) ss += (xv[p][j].x * xv[p][j].x + xv[p][j].y * xv[p][j].y) + (xv[p][j].z * xv[p][j].z + xv[p][j].w * xv[p][j].w);
                    const float rx = 1.0f / sqrtf(wave_sum(ss) * (1.0f / D) + EPS);
#pragma unroll
                    for (int j = 0; j < 8; ++j) { const f32x4 bb = *(const LAS f32x4*)(vB + j * 256 + lo4), cc = *(const LAS f32x4*)(vC + j * 256 + lo4);
                        const f32x4 h = (xv[p][j] * rx) * bb + cc; v2u w; w.x = pk2(h.x, h.y); w.y = pk2(h.z, h.w);
                        *(v2u*)(H + r * D + j * 256 + lo4) = w; }
                }
            }
        }
        __syncthreads();
    }
}

__device__ __forceinline__ void bf8_to_f32(const v4u v, float (&o)[8]) {
    o[0] = __uint_as_float(v.x << 16); o[1] = __uint_as_float(v.x & 0xffff0000u); o[2] = __uint_as_float(v.y << 16); o[3] = __uint_as_float(v.y & 0xffff0000u);
    o[4] = __uint_as_float(v.z << 16); o[5] = __uint_as_float(v.z & 0xffff0000u); o[6] = __uint_as_float(v.w << 16); o[7] = __uint_as_float(v.w & 0xffff0000u);
}
__device__ __forceinline__ void phase_pooled(unsigned char* lds_) {
    Frame F = make_frame(lds_);
    const kptr_t kp = kargs_opaque();
    const bf16* U = WSP(const bf16, WS_Z); bf16* POOLED = WSP(bf16, WS_POOLED);
    for (int item = F.vcu * 512 + F.tid; item < (M / 16) * 128; item += F.G * 512) {
        const int ch = item & 127, run = item >> 7, g = ch >> 5, w = 2 << g, t0 = run * 16, s0 = t0 & (S - 1);
        const bf16* up = U + (size_t)t0 * 1024 + ch * 8;
        v4u rows[31];
#pragma unroll
        for (int i = 0; i < 31; ++i) rows[i] = *(const v4u*)(up + (ptrdiff_t)(i - 15) * 1024);
        float s[8];
#pragma unroll
        for (int k = 0; k < 8; ++k) s[k] = 0.f;
#pragma unroll
        for (int i = 1; i < 16; ++i) { float a[8]; bf8_to_f32(rows[15 - i], a); const bool use = (i < w) && (s0 - i >= 0);
#pragma unroll
            for (int k = 0; k < 8; ++k) s[k] += use ? a[k] : 0.f; }
        bf16* op = POOLED + ((size_t)g * M + t0) * 256 + (ch & 31) * 8;
#pragma unroll
        for (int tt = 0; tt < 16; ++tt) {
            float cur[8]; bf8_to_f32(rows[15 + tt], cur);
            const int cnt = (s0 + tt + 1 < w) ? (s0 + tt + 1) : w; const float rc = 1.0f / (float)cnt;
            float o[8];
#pragma unroll
            for (int k = 0; k < 8; ++k) { s[k] += cur[k]; o[k] = s[k] * rc - cur[k]; }
            v4u ov; ov.x = pk2(o[0], o[1]); ov.y = pk2(o[2], o[3]); ov.z = pk2(o[4], o[5]); ov.w = pk2(o[6], o[7]);
            *(v4u*)(op + (size_t)tt * 256) = ov;
            float q2[8], q4[8], q8[8], q16[8]; bf8_to_f32(rows[15 + tt - 1], q2); bf8_to_f32(rows[15 + tt - 3], q4); bf8_to_f32(rows[15 + tt - 7], q8); bf8_to_f32(rows[15 + tt - 15], q16);
            const bool use = (s0 + tt - w + 1 >= 0);
#pragma unroll
            for (int k = 0; k < 8; ++k) { const float q = (g == 0) ? q2[k] : (g == 1) ? q4[k] : (g == 2) ? q8[k] : q16[k]; s[k] -= use ? q : 0.f; }
        }
    }
}

__device__ __forceinline__ void phase_diffcombine(unsigned char* lds_, int l) {
    Frame F = make_frame(lds_);
    const kptr_t kp = kargs_opaque();
    const float *lq1 = karg<const float>(kp, A_LQ1), *lk1 = karg<const float>(kp, A_LK1), *lq2 = karg<const float>(kp, A_LQ2), *lk2 = karg<const float>(kp, A_LK2), *subln_g = karg<const float>(kp, A_SUBLN);
    const float lam_init = 0.8f - 0.6f * expf(-0.3f * (float)l);
    const float d1 = wave_sum(lq1[l * 64 + F.lane] * lk1[l * 64 + F.lane]), d2 = wave_sum(lq2[l * 64 + F.lane] * lk2[l * 64 + F.lane]);
    const float lam = expf(d1) - expf(d2) + lam_init;
    const float post = 1.0f - lam_init;
    float gsub[16];
#pragma unroll
    for (int k = 0; k < 16; ++k) gsub[k] = subln_g[l * 128 + (F.lane & 7) * 16 + k] * post;
    const bf16 *O0 = WSP(const bf16, WS_O), *O1 = O0 + ZSTRIDE, *GD = WSP(const bf16, WS_Z) + 5 * ZSTRIDE; bf16* MIX = WSP(bf16, WS_MIX);
    const int gw = F.vcu * NWAVES + F.wave, NGW = F.G * NWAVES;
    const unsigned lo16 = (unsigned)F.lane * 16u;
    for (int rr = 2 * gw; rr < M; rr += 2 * NGW) {
        v4u pq[2][2], qq[2][2], gq[2][2];
#pragma unroll
        for (int p = 0; p < 2; ++p)
#pragma unroll
            for (int hh = 0; hh < 2; ++hh) { const size_t off = (size_t)(rr + p) * 1024 + hh * 8;
                pq[p][hh] = *(const v4u*)(O0 + off + lo16); qq[p][hh] = *(const v4u*)(O1 + off + lo16); gq[p][hh] = *(const v4u*)(GD + off + lo16); }
#pragma unroll
        for (int p = 0; p < 2; ++p) {
            float a[16]; float ss = 0.f;
#pragma unroll
            for (int hh = 0; hh < 2; ++hh) { float x0[8], x1[8]; bf8_to_f32(pq[p][hh], x0); bf8_to_f32(qq[p][hh], x1);
#pragma unroll
                for (int k = 0; k < 8; ++k) a[hh * 8 + k] = x0[k] - lam * x1[k]; }
#pragma unroll
            for (int k = 0; k < 16; ++k) ss += a[k] * a[k];
            ss += __shfl_xor(ss, 1); ss += __shfl_xor(ss, 2); ss += __shfl_xor(ss, 4);
            const float rn = 1.0f / sqrtf(ss * (1.0f / 128.0f) + EPS);
#pragma unroll
            for (int hh = 0; hh < 2; ++hh) { float gv[8], o[8]; bf8_to_f32(gq[p][hh], gv);
#pragma unroll
                for (int k = 0; k < 8; ++k) o[k] = a[hh * 8 + k] * rn * gsub[hh * 8 + k] * pg8::silu_f(gv[k]);
                v4u w; w.x = pk2(o[0], o[1]); w.y = pk2(o[2], o[3]); w.z = pk2(o[4], o[5]); w.w = pk2(o[6], o[7]);
                *(v4u*)(MIX + (size_t)(rr + p) * 2048 + 1024 + hh * 8 + lo16) = w; }
        }
    }
}

#define XB_TMO      128
#define XB_XCNT(j)  (256  + 64 * (j))
#define XB_XSUB(j)  (1280 + 64 * (j))
#define XB_XGEN(j)  (2304 + 64 * (j))
#define XB_TOP      3328
#define XB_TOPGEN   3392
#define XCD_BAR_WORDS 3456
#define XB_SPIN_CAP (1u << 18)

__device__ __forceinline__ unsigned xb_ld(unsigned* p)              { return __hip_atomic_load(p, __ATOMIC_RELAXED, __HIP_MEMORY_SCOPE_AGENT); }
__device__ __forceinline__ unsigned xb_add(unsigned* p, unsigned v) { return __hip_atomic_fetch_add(p, v, __ATOMIC_RELAXED, __HIP_MEMORY_SCOPE_AGENT); }
__device__ __forceinline__ unsigned xb_xcc_id() { return (unsigned)__builtin_amdgcn_s_getreg((3 << 11) | 20) & 0xFu; }
#define XB_SPIN(cond, bar) do { unsigned _sp = 0; while (cond) { __builtin_amdgcn_s_sleep(1); \
    if ((++_sp & 255u) == 0u) { if (xb_ld(&(bar)[XB_TMO])) break; if (_sp > XB_SPIN_CAP) { atomicAdd(&(bar)[XB_TMO], 1u); break; } } } } while (0)

struct XcdBarrier {
    unsigned* bar; unsigned x;
    volatile LAS unsigned* st;
};

__device__ __forceinline__ XcdBarrier xcd_barrier_post(unsigned* bar, volatile LAS unsigned* st) {
    XcdBarrier b; b.bar = bar; b.x = xb_xcc_id(); b.st = st;
    if (threadIdx.x == 0) (void)xb_add(&bar[XB_XCNT(b.x)], 1u);
    return b;
}
__device__ __forceinline__ void xcd_barrier_complete(unsigned* bar, unsigned x, unsigned& nloc, unsigned& nx) {
    const unsigned G = gridDim.x * gridDim.y * gridDim.z;
    unsigned sum, cnt, mine, sp = 0u;
    for (;;) {
        sum = 0u; cnt = 0u; mine = 0u;
#pragma unroll
        for (unsigned j = 0; j < 16; ++j) { const unsigned c = xb_ld(&bar[XB_XCNT(j)]); sum += c; cnt += (c > 0u) ? 1u : 0u; mine = (j == x) ? c : mine; }
        if (sum == G) break;
        __builtin_amdgcn_s_sleep(1);
        if ((++sp & 255u) == 0u) { if (xb_ld(&bar[XB_TMO])) break; if (sp > XB_SPIN_CAP) { atomicAdd(&bar[XB_TMO], 1u); break; } }
    }
    nloc = mine > 0u ? mine : 1u; nx = cnt > 0u ? cnt : 1u;
}

__device__ __forceinline__ void xcd_barrier(const XcdBarrier& b) {
    asm volatile("s_waitcnt vmcnt(0)" ::: "memory");
    __syncthreads();
    if (threadIdx.x == 0) {
        unsigned* bar = b.bar;
        __builtin_amdgcn_s_waitcnt(0);
        unsigned nloc = b.st[0], nx = b.st[1];
        if (nloc == 0u) { xcd_barrier_complete(bar, b.x, nloc, nx); b.st[0] = nloc; b.st[1] = nx; }
        const unsigned old = xb_add(&bar[XB_XSUB(b.x)], 1u);
        const unsigned gen = old / nloc;
        if (old + 1u == (gen + 1u) * nloc) {
            __builtin_amdgcn_fence(__ATOMIC_RELEASE, "agent");
            asm volatile("s_waitcnt vmcnt(0)" ::: "memory");
            const unsigned og = xb_add(&bar[XB_TOP], 1u);
            const unsigned tg = og / nx;
            if (og + 1u == (tg + 1u) * nx) xb_add(&bar[XB_TOPGEN], 1u);
            else XB_SPIN(xb_ld(&bar[XB_TOPGEN]) == tg, bar);
            __builtin_amdgcn_fence(__ATOMIC_ACQUIRE, "agent");
            xb_add(&bar[XB_XGEN(b.x)], 1u);
            asm volatile("s_waitcnt vmcnt(0)" ::: "memory");
        } else {
            XB_SPIN(xb_ld(&bar[XB_XGEN(b.x)]) == gen, bar);
            __builtin_amdgcn_fence(__ATOMIC_ACQUIRE, "agent");
            asm volatile("s_waitcnt vmcnt(0)" ::: "memory");
        }
    }
    __syncthreads();
}
struct Args { const void* in[16]; float* out; unsigned char* ws; int ph_lo, ph_hi; };
__global__ void __launch_bounds__(NWAVES * 64, 2) mega_fwd(Args args) {
    extern __shared__ __attribute__((aligned(16))) unsigned char lds[];
    cg::grid_group grid = cg::this_grid();
#if MK_MULTI
    const int lo = args.ph_lo, hi = args.ph_hi;
#define IN(k) (lo <= (k) && (k) < hi)
#define SEAM(k) do { if ((k) + 1 < hi) { grid.sync(); } } while (0)
#else
    if (threadIdx.x < 32) ((LAS unsigned*)((LAS unsigned char*)lds + MISC_OFF))[threadIdx.x] = 0u;
    __syncthreads();
    if (blockIdx.x == 0) { const kptr_t kp = kargs_opaque(); unsigned* bw = WSP(unsigned, WS_CTL) + CW_BAR; for (int i = threadIdx.x; i < XCD_BAR_WORDS; i += NWAVES * 64) bw[i] = 0u; }
#define IN(k) true
#define SEAM(k) do { if ((k) + 1 < N_PHASES) { if ((k) == 0) grid.sync(); else { const kptr_t kp_ = kargs_opaque(); XcdBarrier b_; b_.bar = (unsigned*)(karg<unsigned char>(kp_, A_WS) + WS_CTL) + CW_BAR; b_.x = xb_xcc_id(); \
        b_.st = (volatile LAS unsigned*)((LAS unsigned char*)lds + MISC_OFF) + 8; xcd_barrier(b_); } } } while (0)
#endif

    if (IN(0)) { phase_prologue(lds); SEAM(0); }
    { const kptr_t kp = kargs_opaque(); (void)xcd_barrier_post(WSP(unsigned, WS_CTL) + CW_BAR, (volatile LAS unsigned*)((LAS unsigned char*)lds + MISC_OFF) + 8); }
    if (IN(1)) { phase_rowpass<false, true, true, false>(lds, 0, 0); SEAM(1); }
#pragma unroll 1
    for (int l = 0; l < DEPTH; ++l) {
        const int pb = 2 + 5 * l;
        if (IN(pb)) {
            const kptr_t kp = kargs_opaque();
            pg8::Gemm g{WSP(const bf16, WS_H), WSP(const bf16, WS_WIN) + (size_t)l * DIN * D, M, DIN, D}; pg8::StaticOrder So; So.init(M, DIN, opaque_G(), opaque_bx());
            #if ATTN_V128
            const float qscale = 0.125f * 1.4426950408889634f;
#else
            const float qscale = attn_body::C2;
#endif
            pg8::EpiInProj E{WSP(bf16, WS_Z), ZSTRIDE, WSP(const float, WS_ROPE), WSP(const float, WS_ROPE) + (size_t)M * 32, qscale};
#ifndef NO_G1
            pg8::gemm_phase<pg8::EpiInProj, pg8::StaticOrder, true, true>((LAS unsigned char*)lds, g, So, E);
#endif
            SEAM(pb);
        }
        if (IN(pb + 1)) {
            const kptr_t kp = kargs_opaque();
            bf16* Zp = WSP(bf16, WS_Z); bf16* Op = WSP(bf16, WS_O);
#if ATTN_V128
            const attn2::Tensors AT{(const attn2::bf16*)(Zp + 2 * ZSTRIDE), (const attn2::bf16*)(Zp + 3 * ZSTRIDE), (const attn2::bf16*)(Zp + 4 * ZSTRIDE), (attn2::bf16*)Op, (attn2::bf16*)(Op + ZSTRIDE)};
            attn2::phase((char*)lds, AT, opaque_G(), opaque_bx());
#else
            const attn_body::AttnTensors AT{(const attn_body::bf16*)(Zp + 2 * ZSTRIDE), (const attn_body::bf16*)(Zp + 3 * ZSTRIDE), (const attn_body::bf16*)(Zp + 4 * ZSTRIDE),
                                            (attn_body::bf16*)Op, (attn_body::bf16*)(Op + ZSTRIDE)};
            const attn_body::StaticOrder Sa(opaque_G(), opaque_bx());
#ifndef NO_ATTN
            attn_body::attn_phase<attn_body::StaticOrder>((char*)lds, AT, Sa);
#endif
#endif
            phase_pooled(lds);
            SEAM(pb + 1);
        }
        if (IN(pb + 2)) {
            const kptr_t kp = kargs_opaque();
            int kpool = 256; asm volatile("" : "+s"(kpool));
            pg8::Gemm g{WSP(const bf16, WS_POOLED), WSP(const bf16, WS_WPOOL) + (size_t)l * 4 * 65536, 4 * M, 256, kpool}; pg8::PoolOrder Sp{opaque_G(), opaque_bx()};
            pg8::EpiPool E{WSP(bf16, WS_MIX), WSP(const bf16, WS_Z) + ZSTRIDE, karg<const float>(kp, A_PSCALE) + (size_t)l * 1024};
#ifndef NO_G2
            pg8::gemm_phase<pg8::EpiPool, pg8::PoolOrder, true, true>((LAS unsigned char*)lds, g, Sp, E);
#endif
            phase_diffcombine(lds, l);
            SEAM(pb + 2);
        }
        if (IN(pb + 3)) {
            const kptr_t kp = kargs_opaque();
            pg8::Gemm g{WSP(const bf16, WS_MIX), WSP(const bf16, WS_WOUT) + (size_t)l * D * D, M, D, D}; pg8::StaticOrder So; So.init(M, D, opaque_G(), opaque_bx());
            pg8::EpiPlain E{WSP(bf16, WS_Y), D};
#ifndef NO_G3
            pg8::gemm_phase<pg8::EpiPlain, pg8::StaticOrder, true, true>((LAS unsigned char*)lds, g, So, E);
#endif
            SEAM(pb + 3);
        }
        if (IN(pb + 4)) {
            if (l == 0) phase_rowpass<true, true, true, false>(lds, l, l + 1);
            else if (l + 1 < DEPTH) phase_rowpass<true, true, false, false>(lds, l, l + 1);
            else phase_rowpass<true, false, false, true>(lds, l, l);
            SEAM(pb + 4);
        }
    }
#undef IN
#undef SEAM
}

extern "C" void kernel_launch(void* const* d_in, const int* in_sizes, int n_in, void* d_out, int out_size, void* d_ws, size_t ws_size, hipStream_t stream) {
    static int grid = 0;
    if (grid == 0) {
        if (n_in != 16 || in_sizes[0] != M * D || out_size != M * D || ws_size < WS_END) { fprintf(stderr, "kernel_launch: unexpected shapes (n_in %d, in0 %d, out %d, ws %zu)\n", n_in, n_in > 0 ? in_sizes[0] : -1, out_size, ws_size); grid = -1; return; }
        int dev = 0, cus = 0, per_cu = 0;
        if (hipGetDevice(&dev) != hipSuccess || hipDeviceGetAttribute(&cus, hipDeviceAttributeMultiprocessorCount, dev) != hipSuccess) { fprintf(stderr, "kernel_launch: device query failed\n"); grid = -1; return; }
        if (hipFuncSetAttribute((const void*)mega_fwd, hipFuncAttributeMaxDynamicSharedMemorySize, LDS_BYTES) != hipSuccess) { fprintf(stderr, "kernel_launch: hipFuncSetAttribute failed\n"); grid = -1; return; }
        if (hipOccupancyMaxActiveBlocksPerMultiprocessor(&per_cu, (const void*)mega_fwd, NWAVES * 64, LDS_BYTES) != hipSuccess || per_cu < 1) { fprintf(stderr, "kernel_launch: occupancy query says %d blocks per CU\n", per_cu); per_cu = 1; }
        (void)hipGetLastError();
        grid = cus;
    }
    if (grid < 0) return;
    Args a{};
    for (int i = 0; i < 16; ++i) a.in[i] = d_in[i];
    a.out = (float*)d_out; a.ws = (unsigned char*)d_ws;
#if MK_MULTI
    for (int p = 0; p < N_PHASES; ++p) { a.ph_lo = p; a.ph_hi = p + 1; hipLaunchKernelGGL(mega_fwd, dim3(grid), dim3(NWAVES * 64), LDS_BYTES, stream, a); }
#else
    a.ph_lo = 0; a.ph_hi = N_PHASES;
    void* kargs[] = {&a};
    hipError_t e = hipLaunchCooperativeKernel((const void*)mega_fwd, dim3(grid), dim3(NWAVES * 64), kargs, LDS_BYTES, stream);
    if (e != hipSuccess) fprintf(stderr, "kernel_launch: cooperative launch failed: %s (grid %d)\n", hipGetErrorString(e), grid);
#endif
}
```
